# Optimizing an MI355X kernel written in HIP

```python
import jax, jax.numpy as jnp
from jax import lax
import numpy as np

D_MODEL = 2048
BATCH = 1
SEQ = 16384
DEPTH = 4

MLSTM_HEADS = 4
MLSTM_DK = 128
MLSTM_DV = 256
CONV_WIDTH = 4
GLA_HEADS = 4
GLA_DK = 128
GLA_DV = 256
GLA_GATE_RANK = 16
GLA_GATE_TAU = 16.0
CHUNK = 64
ATTN_HEADS = 16
ATTN_KV_HEADS = 4
ATTN_DH = 128
ROPE_DIM = ATTN_DH // 4
ROPE_THETA = 500000.0
IDX_HEADS = 16
IDX_DH = 64
IDX_ROPE_DIM = IDX_DH // 4
INDEX_TOPK = 256
Q_BLOCK = 128
N_EXPERTS = 16
N_GROUPS = 4
EXPERTS_PER_GROUP = N_EXPERTS // N_GROUPS
GROUP_SCORE_TOPK = 2
TOP_K_EXPERTS = 2
EXPERT_FF = 512
DEEPNORM_ALPHA = (2 * DEPTH) ** 0.25
DEEPNORM_BETA = (8 * DEPTH) ** -0.25
LN_EPS = 1e-5
HEAD_NORM_EPS = 1e-6
MAX_POS_OFFSET = 4096

N_EVEN = (DEPTH + 1) // 2
N_ODD = DEPTH // 2
EVEN_SPLITS = (MLSTM_HEADS * MLSTM_DK, MLSTM_HEADS * MLSTM_DK, MLSTM_HEADS * MLSTM_DV, MLSTM_HEADS, MLSTM_HEADS, MLSTM_HEADS * MLSTM_DV, GLA_HEADS * GLA_DK, GLA_HEADS * GLA_DK, GLA_HEADS * GLA_DV, GLA_GATE_RANK, GLA_HEADS * GLA_DV)
EVEN_IN = sum(EVEN_SPLITS)
MIX_WIDTH = MLSTM_HEADS * MLSTM_DV + GLA_HEADS * GLA_DV
ODD_SPLITS = (ATTN_HEADS * ATTN_DH, ATTN_KV_HEADS * ATTN_DH, ATTN_KV_HEADS * ATTN_DH, IDX_HEADS * IDX_DH, IDX_DH, IDX_HEADS)
ODD_IN = sum(ODD_SPLITS)
ATTN_WIDTH = ATTN_HEADS * ATTN_DH

kernel_name = 'hybrid_mlstm_gla_dsa_moe_deepnorm'


def split_cols(y, sizes):
    cuts = [int(c) for c in np.cumsum(sizes)[:-1]]
    return jnp.split(y, cuts, axis=-1)


def layer_norm(x, gain, bias):
    xf = x.astype(jnp.float32)
    mu = jnp.mean(xf, axis=-1, keepdims=True)
    var = jnp.mean(jnp.square(xf - mu), axis=-1, keepdims=True)
    y = (xf - mu) * lax.rsqrt(var + LN_EPS) * gain.astype(jnp.float32) + bias.astype(jnp.float32)
    return y.astype(x.dtype)


def head_rms_norm(h, gain):
    hn = h * lax.rsqrt(jnp.mean(jnp.square(h), axis=-1, keepdims=True) + HEAD_NORM_EPS)
    return hn.reshape(h.shape[0], h.shape[1], -1) * gain.astype(jnp.float32)


def causal_depthwise_conv(x, w):
    c = x.shape[-1]
    return lax.conv_general_dilated(x, w[:, None, :].astype(x.dtype), window_strides=(1,), padding=[(w.shape[0] - 1, 0)], dimension_numbers=('NWC', 'WIO', 'NWC'), feature_group_count=c)


def partial_rotary(x, positions, rot_dim):
    half = rot_dim // 2
    inv_freq = 1.0 / (ROPE_THETA ** (jnp.arange(half, dtype=jnp.float32) / half))
    ang = positions.astype(jnp.float32)[:, :, None, None] * inv_freq
    cos, sin = jnp.cos(ang), jnp.sin(ang)
    xr = x[..., :rot_dim].astype(jnp.float32)
    x1, x2 = xr[..., :half], xr[..., half:]
    rot = jnp.concatenate([x1 * cos - x2 * sin, x2 * cos + x1 * sin], axis=-1)
    return jnp.concatenate([rot.astype(x.dtype), x[..., rot_dim:]], axis=-1)


def causal_chunk_mask():
    pos = jnp.arange(CHUNK)
    return pos[:, None] >= pos[None, :]


def mlstm_chunked(q, k, v, i_pre, f_pre):
    f32 = jnp.float32
    bsz, t, h, dk = q.shape
    dv = v.shape[-1]
    nc = t // CHUNK
    q = q.astype(f32).reshape(bsz, nc, CHUNK, h, dk)
    k = (k.astype(f32) * dk ** -0.5).reshape(bsz, nc, CHUNK, h, dk)
    v = v.astype(f32).reshape(bsz, nc, CHUNK, h, dv)
    ig = i_pre.astype(f32).reshape(bsz, nc, CHUNK, h)
    lf = jax.nn.log_sigmoid(f_pre.astype(f32)).reshape(bsz, nc, CHUNK, h)
    b = jnp.cumsum(lf, axis=2)
    b_last = b[:, :, -1]
    a = b_last[:, :, None] - b + ig
    m_loc = jnp.max(a, axis=2)
    wk = jnp.exp(a - m_loc[:, :, None])
    c_loc = jnp.einsum('bnjh,bnjhd,bnjhe->bnhde', wk, k, v)
    n_loc = jnp.einsum('bnjh,bnjhd->bnhd', wk, k)

    def step(carry, inp):
        c, n, m = carry
        g, cl, nl, ml = inp
        m_new = jnp.maximum(g + m, ml)
        s_old = jnp.exp(g + m - m_new)
        s_loc = jnp.exp(ml - m_new)
        c_new = s_old[..., None, None] * c + s_loc[..., None, None] * cl
        n_new = s_old[..., None] * n + s_loc[..., None] * nl
        return (c_new, n_new, m_new), (c, n, m)

    init = (jnp.zeros((bsz, h, dk, dv), f32), jnp.zeros((bsz, h, dk), f32), jnp.zeros((bsz, h), f32))
    xs = (jnp.moveaxis(b_last, 1, 0), jnp.moveaxis(c_loc, 1, 0), jnp.moveaxis(n_loc, 1, 0), jnp.moveaxis(m_loc, 1, 0))
    _, (c_prev, n_prev, m_prev) = lax.scan(step, init, xs)
    c_prev = jnp.moveaxis(c_prev, 0, 1)
    n_prev = jnp.moveaxis(n_prev, 0, 1)
    m_prev = jnp.moveaxis(m_prev, 0, 1)
    d_log = b[:, :, :, None, :] - b[:, :, None, :, :] + ig[:, :, None, :, :]
    d_log = jnp.where(causal_chunk_mask()[None, None, :, :, None], d_log, -jnp.inf)
    inter = b + m_prev[:, :, None]
    m_q = jnp.maximum(inter, jnp.max(d_log, axis=3))
    w_ij = jnp.einsum('bnihd,bnjhd->bnijh', q, k) * jnp.exp(d_log - m_q[:, :, :, None])
    s_int = jnp.exp(inter - m_q)
    num = jnp.einsum('bnijh,bnjhe->bnihe', w_ij, v) + s_int[..., None] * jnp.einsum('bnihd,bnhde->bnihe', q, c_prev)
    den = jnp.sum(w_ij, axis=3) + s_int * jnp.einsum('bnihd,bnhd->bnih', q, n_prev)
    out = num / jnp.maximum(jnp.abs(den), jnp.exp(-m_q))[..., None]
    return out.reshape(bsz, t, h, dv)


def gla_chunked(q, k, v, log_a):
    f32 = jnp.float32
    bsz, t, h, dk = q.shape
    dv = v.shape[-1]
    nc = t // CHUNK
    q = (q.astype(f32) * dk ** -0.5).reshape(bsz, nc, CHUNK, h, dk)
    k = k.astype(f32).reshape(bsz, nc, CHUNK, h, dk)
    v = v.astype(f32).reshape(bsz, nc, CHUNK, h, dv)
    la = jnp.cumsum(log_a.astype(f32).reshape(bsz, nc, CHUNK, h, dk), axis=2)
    la_last = la[:, :, -1]
    q_dec = q * jnp.exp(la)
    k_dec = k * jnp.exp(-la)
    k_end = k * jnp.exp(la_last[:, :, None] - la)
    s_loc = jnp.einsum('bnjhd,bnjhe->bnhde', k_end, v)

    def step(s, inp):
        decay, sl = inp
        return jnp.exp(decay)[..., None] * s + sl, s

    _, s_prev = lax.scan(step, jnp.zeros((bsz, h, dk, dv), f32), (jnp.moveaxis(la_last, 1, 0), jnp.moveaxis(s_loc, 1, 0)))
    s_prev = jnp.moveaxis(s_prev, 0, 1)
    attn = jnp.einsum('bnihd,bnjhd->bnijh', q_dec, k_dec)
    attn = jnp.where(causal_chunk_mask()[None, None, :, :, None], attn, 0.0)
    out = jnp.einsum('bnijh,bnjhe->bnihe', attn, v) + jnp.einsum('bnihd,bnhde->bnihe', q_dec, s_prev)
    return out.reshape(bsz, t, h, dv)


def ab_mixer(x, w_in, conv_w, igate_b, fgate_b, gla_w2, gla_b, mlstm_norm_g, gla_norm_g, w_out):
    f32 = jnp.float32
    bsz, t, _ = x.shape
    mq, mk, mv, mi, mf, mo, gq, gk, gv, glr, gr = split_cols(x @ w_in, EVEN_SPLITS)
    qk = jax.nn.silu(causal_depthwise_conv(jnp.concatenate([mq, mk], axis=-1), conv_w))
    mq, mk = jnp.split(qk, 2, axis=-1)
    hm = mlstm_chunked(mq.reshape(bsz, t, MLSTM_HEADS, MLSTM_DK), mk.reshape(bsz, t, MLSTM_HEADS, MLSTM_DK), mv.reshape(bsz, t, MLSTM_HEADS, MLSTM_DV), mi + igate_b, mf + fgate_b)
    hm = head_rms_norm(hm, mlstm_norm_g) * jax.nn.sigmoid(mo.astype(f32))
    log_a = jax.nn.log_sigmoid((glr @ gla_w2 + gla_b).astype(f32)) / GLA_GATE_TAU
    hg = gla_chunked(gq.reshape(bsz, t, GLA_HEADS, GLA_DK), gk.reshape(bsz, t, GLA_HEADS, GLA_DK), gv.reshape(bsz, t, GLA_HEADS, GLA_DV), log_a.reshape(bsz, t, GLA_HEADS, GLA_DK))
    hg = head_rms_norm(hg, gla_norm_g) * jax.nn.silu(gr.astype(f32))
    return jnp.concatenate([hm, hg], axis=-1).astype(x.dtype) @ w_out


def dsa_mixer(x, positions, w_in, w_out):
    f32 = jnp.float32
    bsz, t, _ = x.shape
    q, k, v, qi, ki, wi = split_cols(x @ w_in, ODD_SPLITS)
    q = partial_rotary(q.reshape(bsz, t, ATTN_HEADS, ATTN_DH), positions, ROPE_DIM).astype(f32)
    k = partial_rotary(k.reshape(bsz, t, ATTN_KV_HEADS, ATTN_DH), positions, ROPE_DIM).astype(f32)
    v = v.reshape(bsz, t, ATTN_KV_HEADS, ATTN_DH).astype(f32)
    qi = partial_rotary(qi.reshape(bsz, t, IDX_HEADS, IDX_DH), positions, IDX_ROPE_DIM).astype(f32)
    ki = partial_rotary(ki.reshape(bsz, t, 1, IDX_DH), positions, IDX_ROPE_DIM)[:, :, 0].astype(f32)
    wi = wi.astype(f32) * (IDX_HEADS ** -0.5 * IDX_DH ** -0.5)
    top_k = min(INDEX_TOPK, t // 4)
    n_blk = t // Q_BLOCK
    key_pos = jnp.arange(t)

    def to_blocks(a):
        return jnp.moveaxis(a.reshape(bsz, n_blk, Q_BLOCK, *a.shape[2:]), 1, 0)

    def block(inp):
        qb, qib, wib, qpos = inp
        idx_logits = jnp.einsum('bqhd,bsd->bqhs', qib, ki)
        score = jnp.einsum('bqhs,bqh->bqs', jax.nn.relu(idx_logits), wib)
        score = jnp.where((key_pos[None, :] <= qpos[:, None])[None], score, -jnp.inf)
        _, sel = lax.top_k(score, top_k)
        valid = sel <= qpos[None, :, None]
        k_sel = jax.vmap(lambda kb, ib: kb[ib])(k, sel)
        v_sel = jax.vmap(lambda vb, ib: vb[ib])(v, sel)
        qg = qb.reshape(bsz, Q_BLOCK, ATTN_KV_HEADS, ATTN_HEADS // ATTN_KV_HEADS, ATTN_DH)
        logits = jnp.einsum('bqgrd,bqkgd->bqgrk', qg, k_sel) * ATTN_DH ** -0.5
        logits = jnp.where(valid[:, :, None, None, :], logits, -jnp.inf)
        p = jax.nn.softmax(logits, axis=-1)
        o = jnp.einsum('bqgrk,bqkgd->bqgrd', p, v_sel)
        return o.reshape(bsz, Q_BLOCK, ATTN_WIDTH)

    out = lax.map(block, (to_blocks(q), to_blocks(qi), to_blocks(wi), key_pos.reshape(n_blk, Q_BLOCK)))
    out = jnp.moveaxis(out, 0, 1).reshape(bsz, t, ATTN_WIDTH)
    return out.astype(x.dtype) @ w_out


def moe_ffn(x, router_w, router_bias, w_gate, w_up, w_down):
    f32 = jnp.float32
    aff = jax.nn.sigmoid(jnp.einsum('btd,de->bte', x.astype(f32), router_w.astype(f32)))
    sel = aff + router_bias.astype(f32)
    grp = sel.reshape(sel.shape[0], sel.shape[1], N_GROUPS, EXPERTS_PER_GROUP)
    grp_score = jnp.sum(lax.top_k(grp, GROUP_SCORE_TOPK)[0], axis=-1)
    g = jnp.argmax(grp_score, axis=-1)
    in_grp = jnp.take_along_axis(grp, g[:, :, None, None], axis=2)[:, :, 0]
    _, loc = lax.top_k(in_grp, TOP_K_EXPERTS)
    e_idx = g[..., None] * EXPERTS_PER_GROUP + loc
    gate = jnp.take_along_axis(aff, e_idx, axis=-1)
    gate = gate / jnp.sum(gate, axis=-1, keepdims=True)
    comb = jnp.sum(jax.nn.one_hot(e_idx, N_EXPERTS, dtype=f32) * gate[..., None], axis=-2)
    hg = jnp.einsum('btd,edf->btef', x, w_gate)
    hu = jnp.einsum('btd,edf->btef', x, w_up)
    h = (jax.nn.silu(hg) * hu).astype(f32) * comb[..., None]
    return jnp.einsum('btef,efd->btd', h.astype(x.dtype), w_down)


def setup_inputs(seed: int = 0) -> dict:
    key = jax.random.key(seed)
    ks = jax.random.split(key, 22)
    f32 = jnp.float32

    def nrm(k, shape, scale):
        return jax.random.normal(k, shape, f32) * scale

    x = nrm(ks[0], (BATCH, SEQ, D_MODEL), 1.0)
    positions = jnp.arange(SEQ, dtype=jnp.int32)[None, :] + jax.random.randint(ks[1], (BATCH, 1), 0, MAX_POS_OFFSET, dtype=jnp.int32)
    ab_w_in = nrm(ks[2], (N_EVEN, D_MODEL, EVEN_IN), D_MODEL ** -0.5)
    ab_conv_w = nrm(ks[3], (N_EVEN, CONV_WIDTH, 2 * MLSTM_HEADS * MLSTM_DK), CONV_WIDTH ** -0.5)
    ab_igate_b = nrm(ks[4], (N_EVEN, MLSTM_HEADS), 0.1)
    ab_fgate_b = jnp.linspace(3.0, 6.0, MLSTM_HEADS, dtype=f32)[None, :] + nrm(ks[5], (N_EVEN, MLSTM_HEADS), 0.1)
    ab_gla_gate_w2 = nrm(ks[6], (N_EVEN, GLA_GATE_RANK, GLA_HEADS * GLA_DK), GLA_GATE_RANK ** -0.5)
    ab_gla_gate_b = nrm(ks[7], (N_EVEN, GLA_HEADS * GLA_DK), 0.1)
    ab_mlstm_norm_g = 1.0 + nrm(ks[8], (N_EVEN, MLSTM_HEADS * MLSTM_DV), 0.02)
    ab_gla_norm_g = 1.0 + nrm(ks[9], (N_EVEN, GLA_HEADS * GLA_DV), 0.02)
    ab_w_out = nrm(ks[10], (N_EVEN, MIX_WIDTH, D_MODEL), MIX_WIDTH ** -0.5 * DEEPNORM_BETA)
    c_w_in = nrm(ks[11], (N_ODD, D_MODEL, ODD_IN), D_MODEL ** -0.5)
    c_w_out = nrm(ks[12], (N_ODD, ATTN_WIDTH, D_MODEL), ATTN_WIDTH ** -0.5 * DEEPNORM_BETA)
    router_w = nrm(ks[13], (D_MODEL, N_EXPERTS), D_MODEL ** -0.5)
    router_bias = nrm(ks[14], (N_EXPERTS,), 0.01)
    moe_w_gate = nrm(ks[15], (DEPTH, N_EXPERTS, D_MODEL, EXPERT_FF), D_MODEL ** -0.5)
    moe_w_up = nrm(ks[16], (DEPTH, N_EXPERTS, D_MODEL, EXPERT_FF), D_MODEL ** -0.5)
    moe_w_down = nrm(ks[17], (DEPTH, N_EXPERTS, EXPERT_FF, D_MODEL), EXPERT_FF ** -0.5 * DEEPNORM_BETA)
    ln_mix_g = 1.0 + nrm(ks[18], (DEPTH, D_MODEL), 0.02)
    ln_mix_b = nrm(ks[19], (DEPTH, D_MODEL), 0.02)
    ln_ffn_g = 1.0 + nrm(ks[20], (DEPTH, D_MODEL), 0.02)
    ln_ffn_b = nrm(ks[21], (DEPTH, D_MODEL), 0.02)
    return {'x': x, 'positions': positions, 'ab_w_in': ab_w_in, 'ab_conv_w': ab_conv_w, 'ab_igate_b': ab_igate_b, 'ab_fgate_b': ab_fgate_b, 'ab_gla_gate_w2': ab_gla_gate_w2, 'ab_gla_gate_b': ab_gla_gate_b, 'ab_mlstm_norm_g': ab_mlstm_norm_g, 'ab_gla_norm_g': ab_gla_norm_g, 'ab_w_out': ab_w_out, 'c_w_in': c_w_in, 'c_w_out': c_w_out, 'router_w': router_w, 'router_bias': router_bias, 'moe_w_gate': moe_w_gate, 'moe_w_up': moe_w_up, 'moe_w_down': moe_w_down, 'ln_mix_g': ln_mix_g, 'ln_mix_b': ln_mix_b, 'ln_ffn_g': ln_ffn_g, 'ln_ffn_b': ln_ffn_b}


def reference(x, positions, ab_w_in, ab_conv_w, ab_igate_b, ab_fgate_b, ab_gla_gate_w2, ab_gla_gate_b, ab_mlstm_norm_g, ab_gla_norm_g, ab_w_out, c_w_in, c_w_out, router_w, router_bias, moe_w_gate, moe_w_up, moe_w_down, ln_mix_g, ln_mix_b, ln_ffn_g, ln_ffn_b):
    h = x
    for layer in range(DEPTH):
        j = layer // 2
        if layer % 2 == 0:
            mix = ab_mixer(h, ab_w_in[j], ab_conv_w[j], ab_igate_b[j], ab_fgate_b[j], ab_gla_gate_w2[j], ab_gla_gate_b[j], ab_mlstm_norm_g[j], ab_gla_norm_g[j], ab_w_out[j])
        else:
            mix = dsa_mixer(h, positions, c_w_in[j], c_w_out[j])
        h = layer_norm(DEEPNORM_ALPHA * h + mix, ln_mix_g[layer], ln_mix_b[layer])
        ffn = moe_ffn(h, router_w, router_bias, moe_w_gate[layer], moe_w_up[layer], moe_w_down[layer])
        h = layer_norm(DEEPNORM_ALPHA * h + ffn, ln_ffn_g[layer], ln_ffn_b[layer])
    return h
```

```cpp
#include <hip/hip_runtime.h>
#include <cstdio>
#include <cstdint>
namespace pg8 {
#define PG8_LAS __attribute__((address_space(3)))
typedef unsigned short bf16_t;
typedef short bf16x8 __attribute__((ext_vector_type(8)));
typedef float f32x4 __attribute__((ext_vector_type(4)));
typedef unsigned u32x4 __attribute__((ext_vector_type(4)));
constexpr int BM = 256, BK = 64, HALF = 128, HTB = HALF * BK * 2  , STAGE_BYTES = 8 * HTB, NXCD = 8, WGM = 8;

__host__ __device__ __forceinline__ int lds_byte(int r, int c) { const int st = (r >> 4) * 2 + (c >> 5), rr = r & 15, cc = c & 31, ob = rr * 64 + cc * 2; return st * 1024 + (ob ^ (((ob >> 9) & 1) << 5)); }
__host__ __device__ __forceinline__ void stage_rc(int b, int& R, int& C) { const int st = b / 1024, sb = b % 1024, swz = sb ^ (((sb >> 9) & 1) << 5); R = (st >> 1) * 16 + swz / 64; C = (st & 1) * 32 + (swz % 64) / 2; }
__host__ __device__ __forceinline__ int perm32(int rho) { const int n = rho >> 4, i = rho & 15; return 8 * (i >> 2) + 4 * n + (i & 3); }

struct Unit { int pm, pn; };
struct Gemm { const bf16_t* A; const bf16_t* Bt; int M, N, K; };

struct StaticOrder {
    int nM, nN, nwg, G, c;
    __host__ __device__ void init(int M, int N, int G_, int c_) { nM = M / BM; nN = N / BM; nwg = nM * nN; G = G_; c = c_; }
    __host__ __device__ bool next(int i, Unit& u) const {
        const long L = (long)i * G + c; if (L >= nwg) return false;
        int wgid = (int)L; { const int q = nwg / NXCD, r = nwg % NXCD, xcd = wgid % NXCD, off = wgid / NXCD; wgid = (xcd < r ? xcd * (q + 1) : r * (q + 1) + (xcd - r) * q) + off; }
        const int nig = WGM * nN, gid = wgid / nig, fm = gid * WGM, gsz = (nM - fm) < WGM ? (nM - fm) : WGM;
        u.pm = fm + ((wgid % nig) % gsz); u.pn = (wgid % nig) / gsz; return true;
    }
    __device__ __forceinline__ void a_ready(const Unit&) const {}
    __device__ __forceinline__ void done(const Unit&) const {}
};
__device__ __forceinline__ unsigned cvt_pk_bf16(float lo, float hi) { unsigned r; asm volatile("v_cvt_pk_bf16_f32 %0, %1, %2" : "=v"(r) : "v"(lo), "v"(hi)); return r; }
typedef float f32x2 __attribute__((ext_vector_type(2)));
__device__ __forceinline__ f32x2 gelu_pk(f32x2 v) {
    const f32x2 av = __builtin_elementwise_abs(v), d = av * 0.2316418882f + 1.0f;
    f32x2 t; t.x = __builtin_amdgcn_rcpf(d.x); t.y = __builtin_amdgcn_rcpf(d.y);
    f32x2 q = t * 0.5307027145f + (-0.7265760135f); q = q * t + 0.7107068705f; q = q * t + (-0.142248368f); q = q * t + 0.127414796f; q = q * t;
    const f32x2 s = (v * v) * (-0.72134752044f);
    f32x2 e; e.x = __builtin_amdgcn_exp2f(s.x); e.y = __builtin_amdgcn_exp2f(s.y);
    const f32x2 m = v * (q * e), r = v - m;
    f32x2 o; o.x = v.x < 0.f ? m.x : r.x; o.y = v.y < 0.f ? m.y : r.y; return o;
}


__device__ __forceinline__ u32x4 pack8(const f32x4 v0, const f32x4 v1) { u32x4 w; w.x = cvt_pk_bf16(v0[0], v0[1]); w.y = cvt_pk_bf16(v0[2], v0[3]); w.z = cvt_pk_bf16(v1[0], v1[1]); w.w = cvt_pk_bf16(v1[2], v1[3]); return w; }
struct EpiProj {
    static constexpr bool PERM = true, AFTER_DRAIN = false;
    bf16_t* O; int ldc; int last_pn; float* small;
    __device__ __forceinline__ void operator()(const f32x4 (&acc)[2][2][4][2], const Unit& u, int wr, int wc, int fr, int fq) const {
        const int row0 = u.pm * BM + wr * 64 + fr, col0 = u.pn * BM + wc * 32 + 8 * fq; const bool sm = (u.pn == last_pn);
#pragma unroll
        for (int ai = 0; ai < 2; ++ai)
#pragma unroll
            for (int m = 0; m < 4; ++m) { const int row = row0 + ai * HALF + m * 16; bf16_t* rowp = O + (size_t)row * ldc + col0;
#pragma unroll
                for (int bj = 0; bj < 2; ++bj) *(u32x4*)(rowp + bj * HALF) = pack8(acc[ai][bj][m][0], acc[ai][bj][m][1]);
                if (sm) { float* sp = small + (size_t)row * 128 + wc * 32 + 8 * fq; *(f32x4*)sp = acc[ai][0][m][0]; *(f32x4*)(sp + 4) = acc[ai][0][m][1]; } }
    }
};
struct EpiPlain {
    static constexpr bool PERM = true, AFTER_DRAIN = false;
    bf16_t* O; int ldc; int pn_mod;
    __device__ __forceinline__ void operator()(const f32x4 (&acc)[2][2][4][2], const Unit& u, int wr, int wc, int fr, int fq) const {
        const int row0 = u.pm * BM + wr * 64 + fr, col0 = (u.pn % pn_mod) * BM + wc * 32 + 8 * fq;
#pragma unroll
        for (int ai = 0; ai < 2; ++ai)
#pragma unroll
            for (int m = 0; m < 4; ++m) { bf16_t* rowp = O + (size_t)(row0 + ai * HALF + m * 16) * ldc + col0;
#pragma unroll
                for (int bj = 0; bj < 2; ++bj) *(u32x4*)(rowp + bj * HALF) = pack8(acc[ai][bj][m][0], acc[ai][bj][m][1]); }
    }
};
struct EpiGU {
    static constexpr bool PERM = true, AFTER_DRAIN = false;
    bf16_t* H; const float* gate;
    __device__ __forceinline__ void operator()(const f32x4 (&acc)[2][2][4][2], const Unit& u, int wr, int wc, int fr, int fq) const {
        const int row0 = u.pm * BM + wr * 64 + fr, col0 = (u.pn & 3) * 128 + wc * 32 + 8 * fq;
#pragma unroll
        for (int ai = 0; ai < 2; ++ai)
#pragma unroll
            for (int m = 0; m < 4; ++m) { const int row = row0 + ai * HALF + m * 16; const float gt = gate[row]; f32x4 h0, h1;
#pragma unroll
                for (int j = 0; j < 4; ++j) { const float g0 = acc[ai][0][m][0][j], g1 = acc[ai][0][m][1][j];
                    h0[j] = g0 / (1.0f + __expf(-g0)) * acc[ai][1][m][0][j] * gt; h1[j] = g1 / (1.0f + __expf(-g1)) * acc[ai][1][m][1][j] * gt; }
                *(u32x4*)(H + (size_t)row * 512 + col0) = pack8(h0, h1); }
    }
};
struct MoeOrder {
    int toff[17]; int ncol, G, c;
    __device__ __forceinline__ bool next(int i, Unit& u) const {
        const int L = i * G + c; if (L >= toff[16] * ncol) return false;
        const int pm = L / ncol, pn = L - pm * ncol; int e = 0;
#pragma unroll
        for (int k = 1; k < 16; ++k) e += (toff[k] <= pm) ? 1 : 0;
        u.pm = pm; u.pn = e * ncol + pn; return true;
    }
    __device__ __forceinline__ void a_ready(const Unit&) const {}
    __device__ __forceinline__ void done(const Unit&) const {}
};

template <class Epi, class Sched, bool STAMP = false>
__device__ __forceinline__ void gemm_phase(PG8_LAS unsigned char* lds, const Gemm g, const Sched& S, const Epi& E, unsigned long long* stamps) {
    int tid_ = threadIdx.x; asm volatile("" : "+v"(tid_)); const int tid = tid_, wid = __builtin_amdgcn_readfirstlane(tid >> 6), lane = tid & 63, wr = wid >> 2, wc = wid & 3, fr = lane & 15, fq = lane >> 4;
    const int K = g.K, nt = K / BK;
    int ts_lo = 0, ts_hi = 0, nts = 0; const unsigned long long rt_entry = STAMP ? (unsigned long long)wall_clock64() : 0ull;
#define PG8_STAMP() do { if (STAMP && wid == 0 && nts < 64) { const unsigned long long _c = (unsigned long long)clock64(); \
        ts_lo = (lane == nts) ? (int)(unsigned)_c : ts_lo; ts_hi = (lane == nts) ? (int)(unsigned)(_c >> 32) : ts_hi; ++nts; } } while (0)
    PG8_STAMP();
    unsigned voffA[2], voffB[2];
#pragma unroll
    for (int i = 0; i < 2; ++i) { int R, C; stage_rc(tid * 16 + i * 8192, R, C); const int Rb = Epi::PERM ? ((R & ~31) + perm32(R & 31)) : R;
        voffA[i] = (unsigned)(R * K + C) * 2u; voffB[i] = (unsigned)(Rb * K + C) * 2u; }
    const size_t kstep = (size_t)(BK * 2);
    const size_t hstep = (size_t)HALF * K * 2;
    const size_t tstep = 2 * hstep;
    const unsigned ldsw = (unsigned)wid * 1024u;
    const int aoff = lds_byte(wr * 64 + fr, fq * 8), boff = lds_byte(wc * 32 + fr, fq * 8);
#define PG8_SA(b, h) (((b) * 2 + (h)) * HTB)
#define PG8_SB(b, h) ((4 + (b) * 2 + (h)) * HTB)
#define PG8_STAGE(bufoff, gbase, voff) do { _Pragma("unroll") for (int _i = 0; _i < 2; ++_i) \
        __builtin_amdgcn_global_load_lds((const unsigned*)((const char*)(gbase) + (voff)[_i]), (PG8_LAS unsigned*)(lds + (bufoff) + ldsw + _i * 8192), 16, 0, 0); } while (0)
#define PG8_LDA(dst, b, h) do { _Pragma("unroll") for (int m = 0; m < 4; ++m) _Pragma("unroll") for (int k = 0; k < 2; ++k) dst[m][k] = *(const PG8_LAS bf16x8*)(lds + PG8_SA(b, h) + aoff + m * 2048 + k * 1024); } while (0)
#define PG8_LDB(dst, b, h) do { _Pragma("unroll") for (int n = 0; n < 2; ++n) _Pragma("unroll") for (int k = 0; k < 2; ++k) dst[n][k] = *(const PG8_LAS bf16x8*)(lds + PG8_SB(b, h) + boff + n * 2048 + k * 1024); } while (0)
#define PG8_MMA(ai, bj, At, Bt) do { __builtin_amdgcn_s_setprio(1); _Pragma("unroll") for (int m = 0; m < 4; ++m) _Pragma("unroll") for (int n = 0; n < 2; ++n) _Pragma("unroll") for (int k = 0; k < 2; ++k) \
        acc[ai][bj][m][n] = __builtin_amdgcn_mfma_f32_16x16x32_bf16(Bt[n][k], At[m][k], acc[ai][bj][m][n], 0, 0, 0); __builtin_amdgcn_s_setprio(0); } while (0)
#define PG8_WAIT_V(n) asm volatile("s_waitcnt vmcnt(" #n ")" ::: "memory")
#define PG8_WAIT_L(n) asm volatile("s_waitcnt lgkmcnt(" #n ")" ::: "memory")
#define PG8_BAR __builtin_amdgcn_s_barrier()
#define PG8_SCHED __builtin_amdgcn_sched_barrier(0)
    Unit cur, nxt; int ui = 0;
    if (!S.next(0, cur)) return;
    f32x4 acc[2][2][4][2];
#pragma unroll
    for (int a = 0; a < 2; ++a)
#pragma unroll
        for (int b = 0; b < 2; ++b)
#pragma unroll
            for (int m = 0; m < 4; ++m)
#pragma unroll
                for (int n = 0; n < 2; ++n) acc[a][b][m][n] = (f32x4){0.f, 0.f, 0.f, 0.f};
    bf16x8 At[4][2], B0[2][2], B1[2][2];
    const char* cA = (const char*)g.A + (size_t)cur.pm * tstep; const char* cB = (const char*)g.Bt + (size_t)cur.pn * tstep;
    S.a_ready(cur);
    PG8_STAGE(PG8_SB(0, 0), cB, voffB); PG8_STAGE(PG8_SA(0, 0), cA, voffA); PG8_STAGE(PG8_SB(0, 1), cB + hstep, voffB); PG8_STAGE(PG8_SA(0, 1), cA + hstep, voffA);
    if (wr == 1) PG8_BAR;
    PG8_WAIT_V(4); PG8_BAR;
    PG8_STAGE(PG8_SB(1, 0), cB + kstep, voffB); PG8_STAGE(PG8_SA(1, 0), cA + kstep, voffA); PG8_STAGE(PG8_SB(1, 1), cB + hstep + kstep, voffB);
    PG8_WAIT_V(6); PG8_BAR;
    PG8_STAMP();
    for (;;) {
        const bool has_next = S.next(ui + 1, nxt);
        const char* nA = has_next ? (const char*)g.A + (size_t)nxt.pm * tstep : cA; const char* nB = has_next ? (const char*)g.Bt + (size_t)nxt.pn * tstep : cB;
        for (int t = 0; t < nt; t += 2) {
            const bool last = (t == nt - 2);
            const char* a1 = cA + (size_t)(t + 1) * kstep;
            const char* a2 = last ? nA : cA + (size_t)(t + 2) * kstep; const char* b2 = last ? nB : cB + (size_t)(t + 2) * kstep;
            const char* a3 = a2 + kstep; const char* b3 = b2 + kstep;
            if (last && has_next) S.a_ready(nxt);
            PG8_LDB(B0, 0, 0); PG8_SCHED; PG8_LDA(At, 0, 0); PG8_STAGE(PG8_SA(1, 1), a1 + hstep, voffA);
            PG8_WAIT_L(8); PG8_BAR; PG8_WAIT_L(0); PG8_MMA(0, 0, At, B0); PG8_BAR; PG8_SCHED;
            PG8_LDB(B1, 0, 1); PG8_STAGE(PG8_SB(0, 0), b2, voffB);
            PG8_BAR; PG8_WAIT_L(0); PG8_MMA(0, 1, At, B1); PG8_BAR;
            PG8_LDA(At, 0, 1); PG8_STAGE(PG8_SA(0, 0), a2, voffA);
            PG8_BAR; PG8_WAIT_L(0); PG8_MMA(1, 0, At, B0); PG8_BAR; PG8_SCHED;
            PG8_STAGE(PG8_SB(0, 1), b2 + hstep, voffB);
            PG8_WAIT_V(6); PG8_BAR; PG8_MMA(1, 1, At, B1); PG8_BAR;
            PG8_LDB(B0, 1, 0); PG8_SCHED; PG8_LDA(At, 1, 0); PG8_STAGE(PG8_SA(0, 1), a2 + hstep, voffA);
            PG8_WAIT_L(8); PG8_BAR; PG8_WAIT_L(0); PG8_MMA(0, 0, At, B0); PG8_BAR; PG8_SCHED;
            PG8_LDB(B1, 1, 1); PG8_STAGE(PG8_SB(1, 0), b3, voffB);
            PG8_BAR; PG8_WAIT_L(0); PG8_MMA(0, 1, At, B1); PG8_BAR;
            PG8_LDA(At, 1, 1); PG8_STAGE(PG8_SA(1, 0), a3, voffA);
            PG8_BAR; PG8_WAIT_L(0); PG8_MMA(1, 0, At, B0); PG8_BAR; PG8_SCHED;
            PG8_STAGE(PG8_SB(1, 1), b3 + hstep, voffB);
            PG8_WAIT_V(6); PG8_BAR; PG8_MMA(1, 1, At, B1); PG8_BAR;
        }
        PG8_STAMP();
        if constexpr (!Epi::AFTER_DRAIN) { E(acc, cur, wr, wc, fr, fq); S.done(cur); }
        PG8_STAMP();
        if (!has_next) break;
#pragma unroll
        for (int a = 0; a < 2; ++a)
#pragma unroll
            for (int b = 0; b < 2; ++b)
#pragma unroll
                for (int m = 0; m < 4; ++m)
#pragma unroll
                    for (int n = 0; n < 2; ++n) acc[a][b][m][n] = (f32x4){0.f, 0.f, 0.f, 0.f};
        cur = nxt; cA = nA; cB = nB; ++ui;
    }
    PG8_WAIT_V(0);
    if (wr == 0) PG8_BAR;
    PG8_BAR;
    if constexpr (Epi::AFTER_DRAIN) { E.fused(acc, cur, wr, wc, fr, fq, lds, wid, lane); S.done(cur); }
    PG8_STAMP();
    if (STAMP && wid == 0) { stamps[lane] = lane < nts ? (((unsigned long long)(unsigned)ts_hi << 32) | (unsigned)ts_lo) : 0ull;
        if (lane == 62) stamps[62] = rt_entry; if (lane == 63) stamps[63] = (unsigned long long)wall_clock64(); }
#undef PG8_STAMP
#undef PG8_SA
#undef PG8_SB
#undef PG8_STAGE
#undef PG8_LDA
#undef PG8_LDB
#undef PG8_MMA
#undef PG8_WAIT_V
#undef PG8_WAIT_L
#undef PG8_BAR
#undef PG8_SCHED
}
}

constexpr int T = 16384, D = 2048, DEPTH = 4;
constexpr int NE = 6400, NO = 4352;
constexpr float ALPHA = 1.6817928305074292f;
constexpr float LN_EPS = 1e-5f, HN_EPS = 1e-6f;
constexpr int NWAVES = 8, NTHR = 512;
constexpr int XROWS = 2 * T + 4096;

constexpr int EC_MQ = 0, EC_MK = 512, EC_MV = 1024, EC_MO = 2048, EC_GQ = 3072, EC_GK = 3584, EC_GV = 4096, EC_GR = 5120;
constexpr int OC_Q = 0, OC_K = 2048, OC_V = 2560, OC_QI = 3072;

constexpr size_t MiB = 1u << 20;
constexpr size_t WS_CTL = 0, CTL_ZERO_BYTES = 1 * MiB;
constexpr size_t WS_WINE = 2 * MiB, WS_WINO = 52 * MiB, WS_WOUT = 86 * MiB, WS_WGU = 118 * MiB, WS_WDN = 374 * MiB;
constexpr size_t WS_HB = 502 * MiB, WS_SEL = 566 * MiB, WS_ROPE = 574 * MiB, WS_KI = 576 * MiB, WS_TOK = 578 * MiB, WS_LIST = 579 * MiB, WS_GLIST = 580 * MiB, WS_GS = 581 * MiB;
constexpr size_t WS_MST = 582 * MiB, WS_MPREV = WS_MST + 64 * 1024, WS_NST = 583 * MiB, WS_LAL = 584 * MiB;
constexpr size_t WS_R = 586 * MiB;
constexpr size_t WS_PROJ = WS_R, WS_SMALL = WS_R + 200 * MiB, WS_MIXO = WS_R + 208 * MiB, WS_MIX = WS_R + 272 * MiB, WS_STATES = WS_R + 336 * MiB, WS_QKC = WS_R + 464 * MiB, WS_LA = WS_R + 496 * MiB;
constexpr size_t WS_XG = WS_R, WS_HMID = WS_R + 144 * MiB, WS_Y = WS_R + 180 * MiB;
constexpr size_t WS_END = WS_R + 528 * MiB;
static_assert(WS_Y + (size_t)XROWS * D * 2 <= WS_END && WS_HMID + (size_t)XROWS * 512 * 2 <= WS_Y && WS_XG + (size_t)XROWS * D * 2 <= WS_HMID, "moe overlay");
constexpr int CW_BAR = 4096, CW_CNT = 8192;

constexpr int RING_BYTES = 131072, LDSCTL_OFF = RING_BYTES, LDS_BYTES = 147456;

#define LAS __attribute__((address_space(3)))
typedef unsigned short bf16;
typedef unsigned v4u __attribute__((ext_vector_type(4)));
typedef unsigned v2u __attribute__((ext_vector_type(2)));
typedef float f32x4 __attribute__((ext_vector_type(4)));
typedef float f32x16 __attribute__((ext_vector_type(16)));
typedef short bf16x8 __attribute__((ext_vector_type(8)));
#define LDS_WAIT() asm volatile("s_waitcnt lgkmcnt(0)" ::: "memory")
__device__ __forceinline__ float bf2f(unsigned b) { return __uint_as_float(b << 16); }
__device__ __forceinline__ unsigned f2bf(float f) { unsigned u = __float_as_uint(f); return (u + 0x7fffu + ((u >> 16) & 1u)) >> 16; }
__device__ __forceinline__ unsigned pk2(float lo, float hi) { return f2bf(lo) | (f2bf(hi) << 16); }
__device__ __forceinline__ float lo16(unsigned w) { return __uint_as_float(w << 16); }
__device__ __forceinline__ float hi16(unsigned w) { return __uint_as_float(w & 0xffff0000u); }
__device__ __forceinline__ float sigmoidf_(float x) { return 1.0f / (1.0f + __expf(-x)); }
__device__ __forceinline__ float logsigmoidf_(float x) { return fminf(x, 0.0f) - log1pf(__expf(-fabsf(x))); }
__device__ __forceinline__ float wave_sum(float v) {
#pragma unroll
    for (int o = 1; o < 64; o <<= 1) v += __shfl_xor(v, o);
    return v;
}
__device__ __forceinline__ float wave_max(float v) {
#pragma unroll
    for (int o = 1; o < 64; o <<= 1) v = fmaxf(v, __shfl_xor(v, o));
    return v;
}

#define XB_TMO      128
#define XB_XCNT(j)  (256  + 64 * (j))
#define XB_XSUB(j)  (1280 + 64 * (j))
#define XB_XGEN(j)  (2304 + 64 * (j))
#define XB_TOP      3328
#define XB_TOPGEN   3392
#define XCD_BAR_WORDS 3456
#define XB_SPIN_CAP (1u << 24)
__device__ __forceinline__ unsigned xb_ld(unsigned* p)              { return __hip_atomic_load(p, __ATOMIC_RELAXED, __HIP_MEMORY_SCOPE_AGENT); }
__device__ __forceinline__ unsigned xb_add(unsigned* p, unsigned v) { return __hip_atomic_fetch_add(p, v, __ATOMIC_RELAXED, __HIP_MEMORY_SCOPE_AGENT); }
__device__ __forceinline__ unsigned xb_xcc_id() { return (unsigned)__builtin_amdgcn_s_getreg((3 << 11) | 20) & 0xFu; }
#define XB_SPIN(cond, bar) do { unsigned _sp = 0; while (cond) { __builtin_amdgcn_s_sleep(1); \
    if ((++_sp & 255u) == 0u) { if (xb_ld(&(bar)[XB_TMO])) break; if (_sp > XB_SPIN_CAP) { atomicAdd(&(bar)[XB_TMO], 1u); break; } } } } while (0)
struct XcdBarrier { unsigned* bar; unsigned x; volatile LAS unsigned* st; };
__device__ __forceinline__ XcdBarrier xcd_barrier_post(unsigned* bar, volatile LAS unsigned* st) {
    XcdBarrier b; b.bar = bar; b.x = xb_xcc_id(); b.st = st;
    if (threadIdx.x == 0) (void)xb_add(&bar[XB_XCNT(b.x)], 1u);
    return b;
}
__device__ __forceinline__ void xcd_barrier_complete(unsigned* bar, unsigned x, unsigned& nloc, unsigned& nx) {
    const unsigned G = gridDim.x * gridDim.y * gridDim.z;
    unsigned sum, cnt, mine, sp = 0u;
    for (;;) {
        sum = 0u; cnt = 0u; mine = 0u;
#pragma unroll
        for (unsigned j = 0; j < 16; ++j) { const unsigned c = xb_ld(&bar[XB_XCNT(j)]); sum += c; cnt += (c > 0u) ? 1u : 0u; mine = (j == x) ? c : mine; }
        if (sum == G) break;
        __builtin_amdgcn_s_sleep(1);
        if ((++sp & 255u) == 0u) { if (xb_ld(&bar[XB_TMO])) break; if (sp > XB_SPIN_CAP) { atomicAdd(&bar[XB_TMO], 1u); break; } }
    }
    nloc = mine > 0u ? mine : 1u; nx = cnt > 0u ? cnt : 1u;
}
__device__ __forceinline__ void xcd_barrier(const XcdBarrier& b) {
    asm volatile("s_waitcnt vmcnt(0)" ::: "memory");
    __syncthreads();
    if (threadIdx.x == 0) {
        unsigned* bar = b.bar;
        __builtin_amdgcn_s_waitcnt(0);
        unsigned nloc = b.st[0], nx = b.st[1];
        if (nloc == 0u) { xcd_barrier_complete(bar, b.x, nloc, nx); b.st[0] = nloc; b.st[1] = nx; }
        const unsigned old = xb_add(&bar[XB_XSUB(b.x)], 1u);
        const unsigned gen = old / nloc;
        if (old + 1u == (gen + 1u) * nloc) {
            __builtin_amdgcn_fence(__ATOMIC_RELEASE, "agent");
            asm volatile("s_waitcnt vmcnt(0)" ::: "memory");
            const unsigned og = xb_add(&bar[XB_TOP], 1u);
            const unsigned tg = og / nx;
            if (og + 1u == (tg + 1u) * nx) xb_add(&bar[XB_TOPGEN], 1u);
            else XB_SPIN(xb_ld(&bar[XB_TOPGEN]) == tg, bar);
            __builtin_amdgcn_fence(__ATOMIC_ACQUIRE, "agent");
            xb_add(&bar[XB_XGEN(b.x)], 1u);
            asm volatile("s_waitcnt vmcnt(0)" ::: "memory");
        } else {
            XB_SPIN(xb_ld(&bar[XB_XGEN(b.x)]) == gen, bar);
            __builtin_amdgcn_fence(__ATOMIC_ACQUIRE, "agent");
            asm volatile("s_waitcnt vmcnt(0)" ::: "memory");
        }
    }
    __syncthreads();
}

struct Args {
    const float* x; const int* pos; const float* ab_w_in; const float* ab_conv_w; const float* ab_igate_b; const float* ab_fgate_b; const float* ab_gla_w2; const float* ab_gla_b;
    const float* ab_mnorm; const float* ab_gnorm; const float* ab_w_out; const float* c_w_in; const float* c_w_out; const float* router_w; const float* router_b;
    const float* moe_gate; const float* moe_up; const float* moe_down; const float* ln_mix_g; const float* ln_mix_b; const float* ln_ffn_g; const float* ln_ffn_b;
    float* out; unsigned char* ws; int ph_lo, ph_hi;
};
struct Ctx { LAS unsigned char* lds; int tid, lane, wave; };
__device__ __forceinline__ Ctx make_ctx(LAS unsigned char* lds) { Ctx c; int t = threadIdx.x; asm volatile("" : "+v"(t)); c.lds = lds; c.tid = t; c.lane = t & 63; c.wave = __builtin_amdgcn_readfirstlane(t >> 6); return c; }
__device__ __forceinline__ unsigned char* opaque_ws(const unsigned char* p) { unsigned long long v = (unsigned long long)p; asm volatile("" : "+s"(v)); return (unsigned char*)v; }

__device__ __forceinline__ void xpose_item(const float* W, int ldw, int c0, int k0, bf16* dst, int Kd, LAS float* scr, int lane) {
#pragma unroll 8
    for (int i = 0; i < 32; ++i) { const int kk = 2 * i + (lane >> 5); scr[kk * 33 + (lane & 31)] = W[(size_t)(k0 + kk) * ldw + c0 + (lane & 31)]; }
    LDS_WAIT();
    const int c = lane & 7;
#pragma unroll
    for (int j = 0; j < 4; ++j) { const int n = (lane >> 3) + 8 * j; const LAS float* s = scr + (8 * c) * 33 + n;
        v4u o; o.x = pk2(s[0 * 33], s[1 * 33]); o.y = pk2(s[2 * 33], s[3 * 33]); o.z = pk2(s[4 * 33], s[5 * 33]); o.w = pk2(s[6 * 33], s[7 * 33]);
        *(v4u*)(dst + (size_t)n * Kd + k0 + 8 * c) = o; }
    LDS_WAIT();
}
__device__ __forceinline__ void phase_prologue(const Args& a, LAS unsigned char* lds_) {
    const Ctx c = make_ctx(lds_); unsigned char* ws = opaque_ws(a.ws);
    bf16* WINE = (bf16*)(ws + WS_WINE); bf16* WINO = (bf16*)(ws + WS_WINO); bf16* WOUT = (bf16*)(ws + WS_WOUT); bf16* WGU = (bf16*)(ws + WS_WGU); bf16* WDN = (bf16*)(ws + WS_WDN);
    LAS float* scr = (LAS float*)(c.lds + c.wave * 16384);
    const int gw = blockIdx.x * NWAVES + c.wave, NGW = gridDim.x * NWAVES;
    constexpr int I0 = 65536, I1 = 32768, I2 = 8192, I3 = 2 * 6144, I4 = 2 * 4160, NIT = I0 + I1 + I2 + I3 + I4;
    for (int it = gw; it < NIT; it += NGW) {
        int r = it;
        if (r < I0) { const int nb = r & 3, kb = (r >> 2) & 31, pn = (r >> 7) & 3, which = (r >> 9) & 1, le = r >> 10;
            const float* src = (which ? a.moe_up : a.moe_gate) + (size_t)le * 2048 * 512;
            xpose_item(src, 512, 128 * pn + 32 * nb, 64 * kb, WGU + ((size_t)le * 1024 + 256 * pn + 128 * which + 32 * nb) * 2048, 2048, scr, c.lane); continue; }
        r -= I0;
        if (r < I1) { const int nb = r & 63, kb = (r >> 6) & 7, le = r >> 9;
            xpose_item(a.moe_down + (size_t)le * 512 * 2048, 2048, 32 * nb, 64 * kb, WDN + ((size_t)le * 2048 + 32 * nb) * 512, 512, scr, c.lane); continue; }
        r -= I1;
        if (r < I2) { const int nb = r & 63, kb = (r >> 6) & 31, mat = r >> 11;
            const float* src = mat < 2 ? a.ab_w_out + (size_t)mat * 2048 * 2048 : a.c_w_out + (size_t)(mat - 2) * 2048 * 2048;
            xpose_item(src, 2048, 32 * nb, 64 * kb, WOUT + (size_t)mat * 2048 * 2048 + (size_t)(32 * nb) * 2048, 2048, scr, c.lane); continue; }
        r -= I2;
        if (r < I3) { const int j = r / 6144, q = r % 6144, cb = q % 192, kb = q / 192, d = 32 * cb, sc = d < 2048 ? d : (d < 5120 ? d + 8 : d + 24);
            xpose_item(a.ab_w_in + (size_t)j * 2048 * 6168, 6168, sc, 64 * kb, WINE + (size_t)j * NE * 2048 + (size_t)d * 2048, 2048, scr, c.lane); continue; }
        r -= I3;
        { const int j = r / 4160, q = r % 4160, cb = q % 130, kb = q / 130, d = 32 * cb;
            xpose_item(a.c_w_in + (size_t)j * 2048 * 4176, 4176, d, 64 * kb, WINO + (size_t)j * NO * 2048 + (size_t)d * 2048, 2048, scr, c.lane); }
    }
    const int gt = blockIdx.x * NTHR + c.tid, NT = gridDim.x * NTHR;
    for (int i = gt; i < 2 * 24 * 2048; i += NT) { const int j = i / (24 * 2048), q = i % (24 * 2048), r = q / 2048, k = q % 2048, sc = r < 8 ? 2048 + r : 5128 + (r - 8);
        WINE[(size_t)j * NE * 2048 + (size_t)(6144 + r) * 2048 + k] = (bf16)f2bf(a.ab_w_in[(size_t)j * 2048 * 6168 + (size_t)k * 6168 + sc]); }
    for (int i = gt; i < 2 * 232 * 2048; i += NT) { const int j = i / (232 * 2048), q = i % (232 * 2048); WINE[(size_t)j * NE * 2048 + (size_t)6168 * 2048 + q] = 0; }
    for (int i = gt; i < 2 * 16 * 2048; i += NT) { const int j = i / (16 * 2048), q = i % (16 * 2048), r = q / 2048, k = q % 2048;
        WINO[(size_t)j * NO * 2048 + (size_t)(4160 + r) * 2048 + k] = (bf16)f2bf(a.c_w_in[(size_t)j * 2048 * 4176 + (size_t)k * 4176 + 4160 + r]); }
    for (int i = gt; i < 2 * 176 * 2048; i += NT) { const int j = i / (176 * 2048), q = i % (176 * 2048); WINO[(size_t)j * NO * 2048 + (size_t)4176 * 2048 + q] = 0; }
    { const f32x4* x4 = (const f32x4*)a.x; v4u* hb = (v4u*)(ws + WS_HB);
      for (int i = gt; i < T * D / 8; i += NT) { const f32x4 p = x4[2 * i], q = x4[2 * i + 1]; v4u o; o.x = pk2(p[0], p[1]); o.y = pk2(p[2], p[3]); o.z = pk2(q[0], q[1]); o.w = pk2(q[2], q[3]); hb[i] = o; } }
    { float2* rope = (float2*)(ws + WS_ROPE);
      for (int i = gt; i < T * 16; i += NT) { const int t = i >> 4, f = i & 15; const float inv = 1.0f / powf(500000.0f, (float)f / 16.0f);
          const double ang = (double)a.pos[t] * (double)inv; rope[i] = make_float2((float)cos(ang), (float)sin(ang)); } }
}

template <int MODE> __device__ __forceinline__ void phase_ln(const Args& a, LAS unsigned char* lds_, int layer) {
    const Ctx c = make_ctx(lds_); unsigned char* ws = opaque_ws(a.ws);
    bf16* HB = (bf16*)(ws + WS_HB); const bf16* MIX = (const bf16*)(ws + WS_MIX); const bf16* Y = (const bf16*)(ws + WS_Y);
    unsigned* cnt = (unsigned*)(ws + WS_CTL) + CW_CNT + 64 * layer;
    int4* tok = (int4*)(ws + WS_TOK); int* list = (int*)(ws + WS_LIST); float* glist = (float*)(ws + WS_GLIST);
    const float* g = (MODE == 0 ? a.ln_mix_g : a.ln_ffn_g) + layer * D; const float* b = (MODE == 0 ? a.ln_mix_b : a.ln_ffn_b) + layer * D;
    const int gw = blockIdx.x * NWAVES + c.wave, NGW = gridDim.x * NWAVES, lane = c.lane;
    int soff[16];
    if (MODE == 1) { int acc = 0;
#pragma unroll
        for (int e = 0; e < 16; ++e) { soff[e] = acc; const int ce = (int)__builtin_amdgcn_readfirstlane((int)cnt[e]); acc += (ce + 255) & ~255; } }
    for (int t = gw; t < T; t += NGW) {
        float v[32];
        const bf16* r1 = nullptr; const bf16* r2 = nullptr;
        if (MODE == 0) { r1 = MIX + (size_t)t * D; }
        else { const int4 ti = tok[t]; int p0 = 0, p1 = 0;
#pragma unroll
            for (int e = 0; e < 16; ++e) { if (ti.x == e) p0 = soff[e] + ti.y; if (ti.z == e) p1 = soff[e] + ti.w; }
            r1 = Y + (size_t)p0 * D; r2 = Y + (size_t)p1 * D; }
#pragma unroll
        for (int j = 0; j < 4; ++j) {
            const v4u hv = *(const v4u*)(HB + (size_t)t * D + 512 * j + 8 * lane); const v4u m1 = *(const v4u*)(r1 + 512 * j + 8 * lane);
            v4u m2 = (v4u){0u, 0u, 0u, 0u}; if (MODE == 1) m2 = *(const v4u*)(r2 + 512 * j + 8 * lane);
#pragma unroll
            for (int i = 0; i < 4; ++i) { v[8 * j + 2 * i] = ALPHA * lo16(hv[i]) + lo16(m1[i]) + lo16(m2[i]); v[8 * j + 2 * i + 1] = ALPHA * hi16(hv[i]) + hi16(m1[i]) + hi16(m2[i]); }
        }
        float s = 0.f;
#pragma unroll
        for (int i = 0; i < 32; ++i) s += v[i];
        const float mean = wave_sum(s) * (1.0f / D); float s2 = 0.f;
#pragma unroll
        for (int i = 0; i < 32; ++i) { v[i] -= mean; s2 += v[i] * v[i]; }
        const float rstd = 1.0f / sqrtf(wave_sum(s2) * (1.0f / D) + LN_EPS);
#pragma unroll
        for (int j = 0; j < 4; ++j) { const int col = 512 * j + 8 * lane; const f32x4 g0 = *(const f32x4*)(g + col), g1 = *(const f32x4*)(g + col + 4), b0 = *(const f32x4*)(b + col), b1 = *(const f32x4*)(b + col + 4);
#pragma unroll
            for (int i = 0; i < 4; ++i) { v[8 * j + i] = v[8 * j + i] * rstd * g0[i] + b0[i]; v[8 * j + 4 + i] = v[8 * j + 4 + i] * rstd * g1[i] + b1[i]; } }
        if (MODE == 1 && layer == DEPTH - 1) {
#pragma unroll
            for (int j = 0; j < 4; ++j) { float* o = a.out + (size_t)t * D + 512 * j + 8 * lane; *(f32x4*)o = (f32x4){v[8 * j], v[8 * j + 1], v[8 * j + 2], v[8 * j + 3]}; *(f32x4*)(o + 4) = (f32x4){v[8 * j + 4], v[8 * j + 5], v[8 * j + 6], v[8 * j + 7]}; }
        } else {
#pragma unroll
            for (int j = 0; j < 4; ++j) { v4u o; o.x = pk2(v[8 * j], v[8 * j + 1]); o.y = pk2(v[8 * j + 2], v[8 * j + 3]); o.z = pk2(v[8 * j + 4], v[8 * j + 5]); o.w = pk2(v[8 * j + 6], v[8 * j + 7]);
                *(v4u*)(HB + (size_t)t * D + 512 * j + 8 * lane) = o; }
        }
        if (MODE == 0) {
            float lg[16];
#pragma unroll
            for (int e = 0; e < 16; ++e) lg[e] = 0.f;
#pragma unroll
            for (int j = 0; j < 4; ++j)
#pragma unroll
                for (int i = 0; i < 8; ++i) { const float y = v[8 * j + i]; const f32x4* rw = (const f32x4*)(a.router_w + (size_t)(512 * j + 8 * lane + i) * 16);
#pragma unroll
                    for (int q = 0; q < 4; ++q) { const f32x4 w = rw[q]; lg[4 * q] += y * w[0]; lg[4 * q + 1] += y * w[1]; lg[4 * q + 2] += y * w[2]; lg[4 * q + 3] += y * w[3]; } }
            float aff[16], sel[16];
#pragma unroll
            for (int e = 0; e < 16; ++e) { aff[e] = sigmoidf_(wave_sum(lg[e])); sel[e] = aff[e] + a.router_b[e]; }
            int gbest = 0; float gsbest = -1e30f;
#pragma unroll
            for (int gi = 0; gi < 4; ++gi) { float m1 = -1e30f, m2 = -1e30f;
#pragma unroll
                for (int k = 0; k < 4; ++k) { const float x = sel[4 * gi + k]; if (x > m1) { m2 = m1; m1 = x; } else if (x > m2) m2 = x; }
                const float gs = m1 + m2; if (gs > gsbest) { gsbest = gs; gbest = gi; } }
            float s0 = -1e30f, s1 = -1e30f; int l0 = 0, l1 = 0; float a0 = 0.f, a1 = 0.f;
#pragma unroll
            for (int gi = 0; gi < 4; ++gi) if (gi == gbest) {
#pragma unroll
                for (int k = 0; k < 4; ++k) { const float x = sel[4 * gi + k]; if (x > s0) { s1 = s0; l1 = l0; a1 = a0; s0 = x; l0 = k; a0 = aff[4 * gi + k]; } else if (x > s1) { s1 = x; l1 = k; a1 = aff[4 * gi + k]; } } }
            const int e0 = 4 * gbest + l0, e1 = 4 * gbest + l1; const float inv = 1.0f / (a0 + a1);
            if (lane == 0) { const int sl0 = (int)atomicAdd(&cnt[e0], 1u), sl1 = (int)atomicAdd(&cnt[e1], 1u);
                list[e0 * T + sl0] = t; glist[e0 * T + sl0] = a0 * inv; list[e1 * T + sl1] = t; glist[e1 * T + sl1] = a1 * inv; tok[t] = make_int4(e0, sl0, e1, sl1); }
        }
    }
}

__device__ __forceinline__ void phase_gather(const Args& a, LAS unsigned char* lds_, int layer) {
    const Ctx c = make_ctx(lds_); unsigned char* ws = opaque_ws(a.ws); const bf16* HB = (const bf16*)(ws + WS_HB); bf16* XG = (bf16*)(ws + WS_XG); float* GS = (float*)(ws + WS_GS);
    const unsigned* cnt = (const unsigned*)(ws + WS_CTL) + CW_CNT + 64 * layer; const int* list = (const int*)(ws + WS_LIST); const float* glist = (const float*)(ws + WS_GLIST);
    int soff[17], cn[16]; { int acc = 0;
#pragma unroll
        for (int e = 0; e < 16; ++e) { soff[e] = acc; cn[e] = (int)__builtin_amdgcn_readfirstlane((int)cnt[e]); acc += (cn[e] + 255) & ~255; } soff[16] = acc; }
    const int gw = blockIdx.x * NWAVES + c.wave, NGW = gridDim.x * NWAVES, lane = c.lane;
    for (int p = gw; p < soff[16]; p += NGW) {
        int e = 0, so = 0, ce = 0;
#pragma unroll
        for (int k = 0; k < 16; ++k) if (soff[k] <= p) { e = k; so = soff[k]; ce = cn[k]; }
        const int s = p - so; v4u* dst = (v4u*)(XG + (size_t)p * D);
        if (s < ce) { const int tkn = list[e * T + s]; const v4u* src = (const v4u*)(HB + (size_t)tkn * D);
#pragma unroll
            for (int j = 0; j < 4; ++j) dst[64 * j + lane] = src[64 * j + lane];
            if (lane == 0) GS[p] = glist[e * T + s]; }
        else {
#pragma unroll
            for (int j = 0; j < 4; ++j) dst[64 * j + lane] = (v4u){0u, 0u, 0u, 0u};
            if (lane == 0) GS[p] = 0.f; }
    }
}

#define MFMA32(a, b, c) __builtin_amdgcn_mfma_f32_32x32x16_bf16((a), (b), (c), 0, 0, 0)
__device__ __forceinline__ bf16x8 frag_v(const LAS bf16* p) { return *(const LAS bf16x8*)p; }
__device__ __forceinline__ bf16x8 frag_s(const LAS bf16* p, int stride) { bf16x8 r;
#pragma unroll
    for (int j = 0; j < 8; ++j) r[j] = (short)p[j * stride];
    return r; }
__device__ __forceinline__ int drow(int reg, int h) { return (reg & 3) + 8 * (reg >> 2) + 4 * h; }
__device__ __forceinline__ f32x16 zero16() { f32x16 z;
#pragma unroll
    for (int i = 0; i < 16; ++i) z[i] = 0.f;
    return z; }

constexpr int LQ = 136, LV = 264, LP = 72;
constexpr float RSQ_DK = 0.08838834764831845f;
__device__ __forceinline__ void phase_chunk_a(const Args& a, LAS unsigned char* lds_, int jl) {
    const Ctx c = make_ctx(lds_); unsigned char* ws = opaque_ws(a.ws); const bf16* PROJ = (const bf16*)(ws + WS_PROJ); const float* SMALL = (const float*)(ws + WS_SMALL);
    bf16* ST = (bf16*)(ws + WS_STATES); bf16* QKC = (bf16*)(ws + WS_QKC); float* LA = (float*)(ws + WS_LA);
    float* MST = (float*)(ws + WS_MST); float* NST = (float*)(ws + WS_NST); float* LAL = (float*)(ws + WS_LAL);
    LAS bf16* kw = (LAS bf16*)(c.lds); LAS bf16* vv = (LAS bf16*)(c.lds + 17408); LAS float* wkv = (LAS float*)(c.lds + 51200); LAS float* laf = (LAS float*)(c.lds + 51456);
    const int tid = c.tid, lane = c.lane, wave = c.wave, r = lane & 31, h = lane >> 5;
    for (int u = blockIdx.x; u < 2048; u += gridDim.x) {
        const int n = u >> 3, hh = u & 7, t0 = n * 64;
        __syncthreads();
        if (hh < 4) {
            if (wave == 0) {
                const float* sm = SMALL + (size_t)(t0 + lane) * 128;
                const float ig = sm[hh] + a.ab_igate_b[jl * 4 + hh]; const float lf = logsigmoidf_(sm[4 + hh] + a.ab_fgate_b[jl * 4 + hh]);
                float b = lf;
#pragma unroll
                for (int o = 1; o < 64; o <<= 1) { const float y = __shfl_up(b, o); if (lane >= o) b += y; }
                const float blast = __shfl(b, 63); const float av = blast - b + ig; const float ml = wave_max(av);
                wkv[lane] = __expf(av - ml);
                if (lane == 0) { MST[(n * 4 + hh) * 2] = blast; MST[(n * 4 + hh) * 2 + 1] = ml; }
            }
            __syncthreads();
            for (int it = tid; it < 2048; it += NTHR) {
                const int which = it >> 10, jj = (it >> 4) & 63, c8 = it & 15, t = t0 + jj;
                const int col = (which ? EC_MK : EC_MQ) + hh * 128 + 8 * c8, cch = which * 512 + hh * 128 + 8 * c8;
                float acc[8];
#pragma unroll
                for (int i = 0; i < 8; ++i) acc[i] = 0.f;
#pragma unroll
                for (int w = 0; w < 4; ++w) { const int tt = t - 3 + w; if (tt >= 0) {
                    const v4u xv = *(const v4u*)(PROJ + (size_t)tt * NE + col); const float* cw = a.ab_conv_w + (size_t)(jl * 4 + w) * 1024 + cch; const f32x4 c0 = *(const f32x4*)cw, c1 = *(const f32x4*)(cw + 4);
                    acc[0] += lo16(xv[0]) * c0[0]; acc[1] += hi16(xv[0]) * c0[1]; acc[2] += lo16(xv[1]) * c0[2]; acc[3] += hi16(xv[1]) * c0[3];
                    acc[4] += lo16(xv[2]) * c1[0]; acc[5] += hi16(xv[2]) * c1[1]; acc[6] += lo16(xv[3]) * c1[2]; acc[7] += hi16(xv[3]) * c1[3]; } }
#pragma unroll
                for (int i = 0; i < 8; ++i) acc[i] = acc[i] * sigmoidf_(acc[i]);
                if (which == 0) { v4u o; o.x = pk2(acc[0], acc[1]); o.y = pk2(acc[2], acc[3]); o.z = pk2(acc[4], acc[5]); o.w = pk2(acc[6], acc[7]);
                    *(v4u*)(QKC + (size_t)t * 1024 + hh * 128 + 8 * c8) = o; }
                else {
#pragma unroll
                    for (int i = 0; i < 8; ++i) acc[i] *= RSQ_DK;
                    v4u o; o.x = pk2(acc[0], acc[1]); o.y = pk2(acc[2], acc[3]); o.z = pk2(acc[4], acc[5]); o.w = pk2(acc[6], acc[7]);
                    *(v4u*)(QKC + (size_t)t * 1024 + 512 + hh * 128 + 8 * c8) = o;
                    const float wj = wkv[jj]; v4u p; p.x = pk2(acc[0] * wj, acc[1] * wj); p.y = pk2(acc[2] * wj, acc[3] * wj); p.z = pk2(acc[4] * wj, acc[5] * wj); p.w = pk2(acc[6] * wj, acc[7] * wj);
                    *(LAS v4u*)(kw + jj * LQ + 8 * c8) = p; }
            }
        } else {
            const int g = hh - 4;
            { const int d = tid & 127, jq = tid >> 7; float w2r[16];
#pragma unroll
              for (int q = 0; q < 16; ++q) w2r[q] = a.ab_gla_w2[(size_t)(jl * 16 + q) * 512 + g * 128 + d];
              const float gb = a.ab_gla_b[jl * 512 + g * 128 + d];
              for (int jj = jq * 16; jj < jq * 16 + 16; ++jj) { const float* sm = SMALL + (size_t)(t0 + jj) * 128 + 8; float s = gb;
#pragma unroll
                  for (int q = 0; q < 16; ++q) s += sm[q] * w2r[q];
                  laf[jj * 128 + d] = logsigmoidf_(s) * (1.0f / 16.0f); } }
            __syncthreads();
            if (tid < 128) { float run = 0.f;
                for (int jj = 0; jj < 64; ++jj) { run += laf[jj * 128 + tid]; laf[jj * 128 + tid] = run; LA[(size_t)(t0 + jj) * 512 + g * 128 + tid] = run; }
                LAL[(n * 4 + g) * 128 + tid] = run; }
            __syncthreads();
            for (int it = tid; it < 1024; it += NTHR) { const int jj = it >> 4, c8 = it & 15;
                const v4u kv = *(const v4u*)(PROJ + (size_t)(t0 + jj) * NE + EC_GK + g * 128 + 8 * c8); float kf[8];
#pragma unroll
                for (int i = 0; i < 4; ++i) { kf[2 * i] = lo16(kv[i]); kf[2 * i + 1] = hi16(kv[i]); }
#pragma unroll
                for (int i = 0; i < 8; ++i) kf[i] *= __expf(laf[63 * 128 + 8 * c8 + i] - laf[jj * 128 + 8 * c8 + i]);
                v4u p; p.x = pk2(kf[0], kf[1]); p.y = pk2(kf[2], kf[3]); p.z = pk2(kf[4], kf[5]); p.w = pk2(kf[6], kf[7]);
                *(LAS v4u*)(kw + jj * LQ + 8 * c8) = p; }
        }
        { const int vcol = hh < 4 ? EC_MV + hh * 256 : EC_GV + (hh - 4) * 256;
          for (int it = tid; it < 2048; it += NTHR) { const int jj = it >> 5, c8 = it & 31; *(LAS v4u*)(vv + jj * LV + 8 * c8) = *(const v4u*)(PROJ + (size_t)(t0 + jj) * NE + vcol + 8 * c8); } }
        __syncthreads();
        { const int db = wave & 3;
          for (int e4 = 0; e4 < 4; ++e4) { const int eb = (wave >> 2) * 4 + e4; f32x16 acc = zero16();
#pragma unroll
              for (int ks = 0; ks < 4; ++ks) { const bf16x8 A = frag_s(kw + (16 * ks + 8 * h) * LQ + 32 * db + r, LQ), B = frag_s(vv + (16 * ks + 8 * h) * LV + 32 * eb + r, LV); acc = MFMA32(A, B, acc); }
              bf16* dst = ST + ((size_t)(n * 8 + hh) * 256 + 32 * eb + r) * 128 + 32 * db + 4 * h;
#pragma unroll
              for (int g4 = 0; g4 < 4; ++g4) { v2u w2; w2.x = pk2(acc[4 * g4], acc[4 * g4 + 1]); w2.y = pk2(acc[4 * g4 + 2], acc[4 * g4 + 3]); *(v2u*)(dst + 8 * g4) = w2; } } }
        if (hh < 4 && tid < 128) { float s = 0.f; for (int jj = 0; jj < 64; ++jj) s += bf2f(kw[jj * LQ + tid]); NST[(n * 4 + hh) * 128 + tid] = s; }
    }
}
__device__ __forceinline__ void phase_scan(const Args& a, LAS unsigned char* lds_) {
    const Ctx c = make_ctx(lds_); unsigned char* ws = opaque_ws(a.ws); unsigned* ST = (unsigned*)(ws + WS_STATES);
    const float* MST = (const float*)(ws + WS_MST); float* MPREV = (float*)(ws + WS_MPREV); float* NST = (float*)(ws + WS_NST); const float* LAL = (const float*)(ws + WS_LAL);
    constexpr int NSTR = 8 * 256 * 64;
    for (int p = blockIdx.x * NTHR + c.tid; p < 8 * 256 * 64; p += gridDim.x * NTHR) {
        const int hh = p >> 14, e = (p >> 6) & 255, dp = p & 63;
        unsigned* st = ST + ((size_t)hh * 256 + e) * 64 + dp;
        float c0 = 0.f, c1 = 0.f;
        if (hh < 4) {
            float m = 0.f, n0 = 0.f, n1 = 0.f;
            for (int nb = 0; nb < 256; nb += 16) { unsigned ld[16];
#pragma unroll
                for (int k = 0; k < 16; ++k) ld[k] = st[(size_t)(nb + k) * NSTR];
#pragma unroll
                for (int k = 0; k < 16; ++k) { const int n = nb + k; const float g = MST[(n * 4 + hh) * 2], ml = MST[(n * 4 + hh) * 2 + 1];
                    const float mn = fmaxf(g + m, ml), so = __expf(g + m - mn), sl = __expf(ml - mn);
                    st[(size_t)n * NSTR] = pk2(c0, c1); c0 = so * c0 + sl * lo16(ld[k]); c1 = so * c1 + sl * hi16(ld[k]);
                    if (e == 0) { float2* np = (float2*)(NST + (n * 4 + hh) * 128 + 2 * dp); const float2 nl = *np; *np = make_float2(n0, n1); n0 = so * n0 + sl * nl.x; n1 = so * n1 + sl * nl.y;
                        if (dp == 0) MPREV[n * 4 + hh] = m; }
                    m = mn; } }
        } else {
            const int g = hh - 4;
            for (int nb = 0; nb < 256; nb += 16) { unsigned ld[16];
#pragma unroll
                for (int k = 0; k < 16; ++k) ld[k] = st[(size_t)(nb + k) * NSTR];
#pragma unroll
                for (int k = 0; k < 16; ++k) { const int n = nb + k; const float2 dl = *(const float2*)(LAL + (n * 4 + g) * 128 + 2 * dp);
                    st[(size_t)n * NSTR] = pk2(c0, c1); c0 = __expf(dl.x) * c0 + lo16(ld[k]); c1 = __expf(dl.y) * c1 + hi16(ld[k]); } }
        }
    }
}
__device__ __forceinline__ void phase_chunk_c(const Args& a, LAS unsigned char* lds_, int jl) {
    const Ctx c = make_ctx(lds_); unsigned char* ws = opaque_ws(a.ws); const bf16* PROJ = (const bf16*)(ws + WS_PROJ); const float* SMALL = (const float*)(ws + WS_SMALL);
    const bf16* ST = (const bf16*)(ws + WS_STATES); const bf16* QKC = (const bf16*)(ws + WS_QKC); const float* LA = (const float*)(ws + WS_LA);
    const float* MPREV = (const float*)(ws + WS_MPREV); const float* NST = (const float*)(ws + WS_NST); bf16* MIXO = (bf16*)(ws + WS_MIXO);
    LAS bf16* qa = (LAS bf16*)(c.lds); LAS bf16* kb = (LAS bf16*)(c.lds + 17408); LAS bf16* vv = (LAS bf16*)(c.lds + 34816); LAS bf16* P = (LAS bf16*)(c.lds + 68608);
    LAS float* bvec = (LAS float*)(c.lds + 77824); LAS float* igv = bvec + 64; LAS float* mqv = bvec + 128; LAS float* sint = bvec + 192; LAS float* dn = bvec + 256; LAS float* rstd = bvec + 320;
    LAS float* rsq = bvec + 384; LAS float* nprev = bvec + 384 + 512; LAS bf16* qsm = (LAS bf16*)(c.lds + 81920); LAS bf16* ost = (LAS bf16*)(c.lds + 99328);
    const int tid = c.tid, lane = c.lane, wave = c.wave, r = lane & 31, h = lane >> 5;
    for (int u = blockIdx.x; u < 2048; u += gridDim.x) {
        const int n = u >> 3, hh = u & 7, t0 = n * 64, g = hh - 4;
        LAS bf16* qs = hh < 4 ? qsm : qa;
        __syncthreads();
        if (hh < 4 && wave == 0) {
            const float* sm = SMALL + (size_t)(t0 + lane) * 128;
            const float ig = sm[hh] + a.ab_igate_b[jl * 4 + hh]; const float lf = logsigmoidf_(sm[4 + hh] + a.ab_fgate_b[jl * 4 + hh]);
            float b = lf;
#pragma unroll
            for (int o = 1; o < 64; o <<= 1) { const float y = __shfl_up(b, o); if (lane >= o) b += y; }
            float mx = ig - b;
#pragma unroll
            for (int o = 1; o < 64; o <<= 1) { const float y = __shfl_up(mx, o); if (lane >= o) mx = fmaxf(mx, y); }
            const float mp = MPREV[n * 4 + hh]; const float mq = b + fmaxf(mp, mx);
            bvec[lane] = b; igv[lane] = ig; mqv[lane] = mq; sint[lane] = __expf(b + mp - mq);
        }
        __syncthreads();
        if (hh < 4) {
            for (int it = tid; it < 2048; it += NTHR) { const int which = it >> 10, jj = (it >> 4) & 63, c8 = it & 15;
                const v4u x = *(const v4u*)(QKC + (size_t)(t0 + jj) * 1024 + which * 512 + hh * 128 + 8 * c8);
                *(LAS v4u*)((which ? kb : qa) + jj * LQ + 8 * c8) = x;
                if (which == 0) { const float si = sint[jj]; v4u y;
#pragma unroll
                    for (int i = 0; i < 4; ++i) y[i] = pk2(lo16(x[i]) * si, hi16(x[i]) * si);
                    *(LAS v4u*)(qsm + jj * LQ + 8 * c8) = y; } }
            if (tid < 128) nprev[tid] = NST[(n * 4 + hh) * 128 + tid];
        } else {
            for (int it = tid; it < 1024; it += NTHR) { const int jj = it >> 4, c8 = it & 15; const size_t t = t0 + jj;
                const v4u qv = *(const v4u*)(PROJ + t * NE + EC_GQ + g * 128 + 8 * c8), kv = *(const v4u*)(PROJ + t * NE + EC_GK + g * 128 + 8 * c8);
                const f32x4 l0 = *(const f32x4*)(LA + t * 512 + g * 128 + 8 * c8), l1 = *(const f32x4*)(LA + t * 512 + g * 128 + 8 * c8 + 4);
                float qf[8], kf[8], el[8];
#pragma unroll
                for (int i = 0; i < 4; ++i) { qf[2 * i] = lo16(qv[i]); qf[2 * i + 1] = hi16(qv[i]); kf[2 * i] = lo16(kv[i]); kf[2 * i + 1] = hi16(kv[i]); el[i] = l0[i]; el[4 + i] = l1[i]; }
#pragma unroll
                for (int i = 0; i < 8; ++i) { qf[i] *= RSQ_DK * __expf(el[i]); kf[i] *= __expf(-el[i]); }
                v4u o; o.x = pk2(qf[0], qf[1]); o.y = pk2(qf[2], qf[3]); o.z = pk2(qf[4], qf[5]); o.w = pk2(qf[6], qf[7]); *(LAS v4u*)(qa + jj * LQ + 8 * c8) = o;
                v4u p; p.x = pk2(kf[0], kf[1]); p.y = pk2(kf[2], kf[3]); p.z = pk2(kf[4], kf[5]); p.w = pk2(kf[6], kf[7]); *(LAS v4u*)(kb + jj * LQ + 8 * c8) = p; }
        }
        { const int vcol = hh < 4 ? EC_MV + hh * 256 : EC_GV + g * 256;
          for (int it = tid; it < 2048; it += NTHR) { const int jj = it >> 5, c8 = it & 31; *(LAS v4u*)(vv + jj * LV + 8 * c8) = *(const v4u*)(PROJ + (size_t)(t0 + jj) * NE + vcol + 8 * c8); } }
        __syncthreads();
        if (wave < 4) { const int ib = wave >> 1, jb = wave & 1; f32x16 acc = zero16();
            if (jb <= ib) {
#pragma unroll
                for (int ks = 0; ks < 8; ++ks) { const bf16x8 A = frag_v(qa + (32 * ib + r) * LQ + 16 * ks + 8 * h), B = frag_v(kb + (32 * jb + r) * LQ + 16 * ks + 8 * h); acc = MFMA32(A, B, acc); } }
            const int jc = 32 * jb + r;
#pragma unroll
            for (int reg = 0; reg < 16; ++reg) { const int i = 32 * ib + drow(reg, h); float wv = 0.f;
                if (jc <= i) wv = hh < 4 ? acc[reg] * __expf(bvec[i] - bvec[jc] + igv[jc] - mqv[i]) : acc[reg];
                P[i * LP + jc] = (bf16)f2bf(wv); } }
        __syncthreads();
        if (hh < 4 && tid < 64) { const int i = tid; float s = 0.f; for (int jj = 0; jj < 64; ++jj) s += bf2f(P[i * LP + jj]);
            float qn = 0.f; for (int d = 0; d < 128; ++d) qn += bf2f(qa[i * LQ + d]) * nprev[d];
            dn[i] = fmaxf(fabsf(s + sint[i] * qn), __expf(-mqv[i])); }
        const int eb = wave;
#pragma unroll 1
        for (int ib = 0; ib < 2; ++ib) { f32x16 acc = zero16();
#pragma unroll
            for (int ks = 0; ks < 4; ++ks) { const bf16x8 B = frag_s(vv + (16 * ks + 8 * h) * LV + 32 * eb + r, LV), A = frag_v(P + (32 * ib + r) * LP + 16 * ks + 8 * h); acc = MFMA32(A, B, acc); }
#pragma unroll
            for (int ks = 0; ks < 8; ++ks) { const bf16x8 B = *(const bf16x8*)(ST + ((size_t)(n * 8 + hh) * 256 + 32 * eb + r) * 128 + 16 * ks + 8 * h), A = frag_v(qs + (32 * ib + r) * LQ + 16 * ks + 8 * h); acc = MFMA32(A, B, acc); }
#pragma unroll
            for (int reg = 0; reg < 16; ++reg) { const int i = 32 * ib + drow(reg, h); const float o = acc[reg]; ost[i * LV + 32 * eb + r] = (bf16)f2bf(o); float sq = o * o;
#pragma unroll
                for (int of = 1; of < 32; of <<= 1) sq += __shfl_xor(sq, of);
                if (r == 0) rsq[i * 8 + wave] = sq; } }
        __syncthreads();
        if (tid < 64) { float s = 0.f;
#pragma unroll
            for (int w = 0; w < 8; ++w) s += rsq[tid * 8 + w];
            const float inv = hh < 4 ? 1.0f / dn[tid] : 1.0f;
            rstd[tid] = inv / sqrtf(s * inv * inv * (1.0f / 256.0f) + HN_EPS); }
        __syncthreads();
        { const float* gainp = hh < 4 ? a.ab_mnorm + jl * 1024 + hh * 256 : a.ab_gnorm + jl * 1024 + g * 256;
          const int gcol = hh < 4 ? EC_MO + hh * 256 : EC_GR + g * 256, ocol = hh < 4 ? hh * 256 : 1024 + g * 256;
          for (int it = tid; it < 2048; it += NTHR) { const int i = it >> 5, c8 = it & 31; const size_t t = t0 + i;
              const v4u nv = *(const LAS v4u*)(ost + i * LV + 8 * c8), gv = *(const v4u*)(PROJ + t * NE + gcol + 8 * c8);
              const f32x4 g0 = *(const f32x4*)(gainp + 8 * c8), g1 = *(const f32x4*)(gainp + 8 * c8 + 4); const float rs = rstd[i]; float o[8];
#pragma unroll
              for (int k = 0; k < 4; ++k) { const float x0 = lo16(gv[k]), x1 = hi16(gv[k]); const float t0g = hh < 4 ? sigmoidf_(x0) : x0 * sigmoidf_(x0), t1g = hh < 4 ? sigmoidf_(x1) : x1 * sigmoidf_(x1);
                  o[2 * k] = lo16(nv[k]) * rs * t0g; o[2 * k + 1] = hi16(nv[k]) * rs * t1g; }
              v4u w; w.x = pk2(o[0] * g0[0], o[1] * g0[1]); w.y = pk2(o[2] * g0[2], o[3] * g0[3]); w.z = pk2(o[4] * g1[0], o[5] * g1[1]); w.w = pk2(o[6] * g1[2], o[7] * g1[3]);
              *(v4u*)(MIXO + t * D + ocol + 8 * c8) = w; } }
    }
}

__device__ __forceinline__ void phase_rope(const Args& a, LAS unsigned char* lds_) {
    const Ctx c = make_ctx(lds_); unsigned char* ws = opaque_ws(a.ws); bf16* PROJ = (bf16*)(ws + WS_PROJ); const float* SMALL = (const float*)(ws + WS_SMALL); const float2* ROPE = (const float2*)(ws + WS_ROPE); bf16* KI = (bf16*)(ws + WS_KI);
    const int gw = blockIdx.x * NWAVES + c.wave, NGW = gridDim.x * NWAVES, lane = c.lane;
    for (int t = gw; t < T; t += NGW) {
        const float2* rp = ROPE + (size_t)t * 16; bf16* pr = PROJ + (size_t)t * NO;
        for (int it = lane; it < 320; it += 64) { const int hq = it >> 4, i = it & 15, col = hq < 16 ? OC_Q + hq * 128 : OC_K + (hq - 16) * 128;
            const float x1 = bf2f(pr[col + i]), x2 = bf2f(pr[col + 16 + i]); const float2 cs = rp[i];
            pr[col + i] = (bf16)f2bf(x1 * cs.x - x2 * cs.y); pr[col + 16 + i] = (bf16)f2bf(x2 * cs.x + x1 * cs.y); }
        for (int it = lane; it < 128; it += 64) { const int hq = it >> 3, i = it & 7, col = OC_QI + hq * 64;
            const float x1 = bf2f(pr[col + i]), x2 = bf2f(pr[col + 8 + i]); const float2 cs = rp[2 * i];
            pr[col + i] = (bf16)f2bf(x1 * cs.x - x2 * cs.y); pr[col + 8 + i] = (bf16)f2bf(x2 * cs.x + x1 * cs.y); }
        { const float* sm = SMALL + (size_t)t * 128; const int d = lane; const float x = sm[d]; float o = x;
          if (d < 8) { const float2 cs = rp[2 * d]; o = x * cs.x - sm[d + 8] * cs.y; }
          else if (d < 16) { const float2 cs = rp[2 * (d - 8)]; o = x * cs.x + sm[d - 8] * cs.y; }
          KI[(size_t)t * 64 + d] = (bf16)f2bf(o); }
    }
}
__device__ __forceinline__ unsigned short score_code(float s) { const _Float16 hv = (_Float16)s; const unsigned short hb = __builtin_bit_cast(unsigned short, hv); return (hb & 0x8000u) ? (unsigned short)~hb : (unsigned short)(hb | 0x8000u); }
__device__ __forceinline__ void find_bin(const LAS unsigned* hist, int target, int lane, int& bin, int& above) {
    const int h0 = (int)hist[4 * lane], h1 = (int)hist[4 * lane + 1], h2 = (int)hist[4 * lane + 2], h3 = (int)hist[4 * lane + 3]; const int s = h0 + h1 + h2 + h3; int x = s;
#pragma unroll
    for (int o = 1; o < 64; o <<= 1) { const int y = __shfl_down(x, o); if (lane + o < 64) x += y; }
    const int suf = x - s; const bool found = (suf < target) && (suf + s >= target);
    int b = 0, ab = 0; { int run = suf;
        if (run + h3 >= target) { b = 4 * lane + 3; ab = run; } else { run += h3;
        if (run + h2 >= target) { b = 4 * lane + 2; ab = run; } else { run += h2;
        if (run + h1 >= target) { b = 4 * lane + 1; ab = run; } else { run += h1; b = 4 * lane; ab = run; } } } }
    const unsigned long long m = __ballot(found); const int src = m ? (int)__builtin_ctzll(m) : 0;
    bin = __shfl(b, src); above = __shfl(ab, src);
}
__device__ __forceinline__ void phase_index(const Args& a, LAS unsigned char* lds_) {
    const Ctx c = make_ctx(lds_); unsigned char* ws = opaque_ws(a.ws); const bf16* PROJ = (const bf16*)(ws + WS_PROJ); const float* SMALL = (const float*)(ws + WS_SMALL); const bf16* KI = (const bf16*)(ws + WS_KI); unsigned short* SEL = (unsigned short*)(ws + WS_SEL);
    LAS unsigned short* codes = (LAS unsigned short*)c.lds; LAS unsigned* hist = (LAS unsigned*)(c.lds + 131072);
    const int lane = c.lane, wave = c.wave, r = lane & 31, h = lane >> 5;
    for (int task = blockIdx.x; task < T / 4; task += gridDim.x) {
        const int t0 = 4 * (T / 4 - 1 - task), nkt = (t0 + 4 + 31) >> 5;
        __syncthreads();
        bf16x8 A[2][4]; float wv[2][2][8];
#pragma unroll
        for (int rb = 0; rb < 2; ++rb) {
#pragma unroll
            for (int ks = 0; ks < 4; ++ks) A[rb][ks] = *(const bf16x8*)(PROJ + (size_t)(t0 + 2 * rb + (r >> 4)) * NO + OC_QI + (r & 15) * 64 + 16 * ks + 8 * h);
#pragma unroll
            for (int qq = 0; qq < 2; ++qq)
#pragma unroll
                for (int k8 = 0; k8 < 8; ++k8) wv[rb][qq][k8] = SMALL[(size_t)(t0 + 2 * rb + qq) * 128 + 64 + (k8 & 3) + 8 * (k8 >> 2) + 4 * h] * (1.0f / 32.0f); }
        for (int kt = wave; kt < nkt; kt += NWAVES) { const int key = 32 * kt + r; bf16x8 B[4];
#pragma unroll
            for (int ks = 0; ks < 4; ++ks) B[ks] = *(const bf16x8*)(KI + (size_t)key * 64 + 16 * ks + 8 * h);
#pragma unroll
            for (int rb = 0; rb < 2; ++rb) { f32x16 acc = zero16();
#pragma unroll
                for (int ks = 0; ks < 4; ++ks) acc = MFMA32(A[rb][ks], B[ks], acc);
                float s0 = 0.f, s1 = 0.f;
#pragma unroll
                for (int k8 = 0; k8 < 8; ++k8) { s0 += wv[rb][0][k8] * fmaxf(acc[k8], 0.f); s1 += wv[rb][1][k8] * fmaxf(acc[8 + k8], 0.f); }
                s0 += __shfl_xor(s0, 32); s1 += __shfl_xor(s1, 32);
                const int qq = 2 * rb + h; const float sc = h ? s1 : s0;
                codes[qq * 16384 + key] = (key <= t0 + qq) ? score_code(sc) : (unsigned short)0; } }
        __syncthreads();
        if (wave < 4) { const int t = t0 + wave, nv = t + 1; const LAS unsigned short* cd = codes + wave * 16384; LAS unsigned* hs = hist + wave * 512; unsigned short* out = SEL + (size_t)t * 256;
            if (nv <= 256) { for (int i = lane; i < nv; i += 64) out[i] = (unsigned short)i; }
            else {
#pragma unroll
                for (int q = 0; q < 8; ++q) hs[64 * q + lane] = 0u;
                LDS_WAIT();
                for (int i = lane; i < nv; i += 64) __hip_atomic_fetch_add(hs + (cd[i] >> 8), 1u, __ATOMIC_RELAXED, __HIP_MEMORY_SCOPE_WORKGROUP);
                LDS_WAIT();
                int b1, ab1; find_bin(hs, 256, lane, b1, ab1);
                for (int i = lane; i < nv; i += 64) { const unsigned cv = cd[i]; if ((int)(cv >> 8) == b1) __hip_atomic_fetch_add(hs + 256 + (cv & 255u), 1u, __ATOMIC_RELAXED, __HIP_MEMORY_SCOPE_WORKGROUP); }
                LDS_WAIT();
                int b2, ab2; find_bin(hs + 256, 256 - ab1, lane, b2, ab2);
                const unsigned thr = ((unsigned)b1 << 8) | (unsigned)b2; const int need_eq = 256 - ab1 - ab2; int run = 0, run_eq = 0;
                const unsigned long long ltm = (1ull << lane) - 1ull;
                for (int base = 0; base < nv; base += 64) { const int i = base + lane; const unsigned cv = i < nv ? (unsigned)cd[i] : 0u; const bool gt = cv > thr, eq = (cv == thr) && (i < nv);
                    const unsigned long long meq = __ballot(eq); const bool take = gt || (eq && (run_eq + __popcll(meq & ltm) < need_eq));
                    const unsigned long long mt = __ballot(take); const int pos = run + __popcll(mt & ltm);
                    if (take && pos < 256) out[pos] = (unsigned short)i;
                    run += __popcll(mt); run_eq += __popcll(meq); }
            } }
    }
}
__device__ __forceinline__ void phase_attn(const Args& a, LAS unsigned char* lds_) {
    const Ctx c = make_ctx(lds_); unsigned char* ws = opaque_ws(a.ws); const bf16* PROJ = (const bf16*)(ws + WS_PROJ); const unsigned short* SEL = (const unsigned short*)(ws + WS_SEL); bf16* MIXO = (bf16*)(ws + WS_MIXO);
    LAS float* qf = (LAS float*)(c.lds + c.wave * 6144); LAS float* pf = qf + 512;
    const int lane = c.lane;
    for (int task = blockIdx.x * NWAVES + c.wave; task < T * 4; task += gridDim.x * NWAVES) {
        const int t = T - 1 - (task >> 2), g = task & 3, nk = t + 1 < 256 ? t + 1 : 256;
        for (int i = lane; i < 512; i += 64) qf[i] = bf2f(PROJ[(size_t)t * NO + OC_Q + (4 * g + (i >> 7)) * 128 + (i & 127)]) * RSQ_DK;
        LDS_WAIT();
        int keys[4]; float lg[4][4];
#pragma unroll
        for (int kk = 0; kk < 4; ++kk) { const int k = lane + 64 * kk; keys[kk] = 0;
#pragma unroll
            for (int q = 0; q < 4; ++q) lg[kk][q] = -1e30f;
            if (k < nk) { const int key = SEL[(size_t)t * 256 + k]; keys[kk] = key; const v4u* kr = (const v4u*)(PROJ + (size_t)key * NO + OC_K + g * 128); float acc[4] = {0.f, 0.f, 0.f, 0.f};
#pragma unroll 4
                for (int cc = 0; cc < 16; ++cc) { const v4u kv = kr[cc]; float kf[8];
#pragma unroll
                    for (int i = 0; i < 4; ++i) { kf[2 * i] = lo16(kv[i]); kf[2 * i + 1] = hi16(kv[i]); }
#pragma unroll
                    for (int q = 0; q < 4; ++q) { const f32x4 q0 = *(const LAS f32x4*)(qf + q * 128 + 8 * cc), q1 = *(const LAS f32x4*)(qf + q * 128 + 8 * cc + 4);
                        acc[q] += kf[0] * q0[0] + kf[1] * q0[1] + kf[2] * q0[2] + kf[3] * q0[3] + kf[4] * q1[0] + kf[5] * q1[1] + kf[6] * q1[2] + kf[7] * q1[3]; } }
#pragma unroll
                for (int q = 0; q < 4; ++q) lg[kk][q] = acc[q]; } }
#pragma unroll
        for (int q = 0; q < 4; ++q) { float m = fmaxf(fmaxf(lg[0][q], lg[1][q]), fmaxf(lg[2][q], lg[3][q])); m = wave_max(m); float e[4], s = 0.f;
#pragma unroll
            for (int kk = 0; kk < 4; ++kk) { e[kk] = (lane + 64 * kk < nk) ? __expf(lg[kk][q] - m) : 0.f; s += e[kk]; }
            s = wave_sum(s); const float inv = 1.0f / s;
#pragma unroll
            for (int kk = 0; kk < 4; ++kk) pf[(lane + 64 * kk) * 4 + q] = e[kk] * inv; }
        LDS_WAIT();
        float o[4][2];
#pragma unroll
        for (int q = 0; q < 4; ++q) { o[q][0] = 0.f; o[q][1] = 0.f; }
#pragma unroll
        for (int kk = 0; kk < 4; ++kk) { const int lim = nk - 64 * kk < 64 ? nk - 64 * kk : 64;
#pragma unroll 8
            for (int l = 0; l < lim; ++l) { const int key = __builtin_amdgcn_readlane(keys[kk], l); const unsigned vw = *(const unsigned*)(PROJ + (size_t)key * NO + OC_V + g * 128 + 2 * lane);
                const f32x4 p = *(const LAS f32x4*)(pf + (64 * kk + l) * 4); const float v0 = lo16(vw), v1 = hi16(vw);
#pragma unroll
                for (int q = 0; q < 4; ++q) { o[q][0] += p[q] * v0; o[q][1] += p[q] * v1; } } }
#pragma unroll
        for (int q = 0; q < 4; ++q) *(unsigned*)(MIXO + (size_t)t * D + (4 * g + q) * 128 + 2 * lane) = pk2(o[q][0], o[q][1]);
    }
}

constexpr int N_PHASES = 1 + 10 * DEPTH;
#ifndef PHASE_MASK
#define PHASE_MASK 0xFFFF
#endif
#define EN(k) ((PHASE_MASK >> (k)) & 1)
__global__ void __launch_bounds__(NTHR, 2) fwd(Args a) {
    extern __shared__ __attribute__((aligned(16))) unsigned char lds_raw[];
    LAS unsigned char* lds = (LAS unsigned char*)lds_raw;
    volatile LAS unsigned* xbw = (volatile LAS unsigned*)(lds + LDS_BYTES - 64);
    if (threadIdx.x < 16) xbw[threadIdx.x] = 0u;
    __syncthreads();
    unsigned char* const ws0 = a.ws;
    XcdBarrier bar; bar.bar = (unsigned*)(ws0 + WS_CTL) + CW_BAR; bar.x = 0; bar.st = xbw;
    const int lo = a.ph_lo, hi = a.ph_hi;
    if (hi - lo > 1) bar = xcd_barrier_post((unsigned*)(ws0 + WS_CTL) + CW_BAR, xbw);
#define IN(k) (lo <= (k) && (k) < hi)
#define SEAM(k) do { if (IN(k) && IN((k) + 1)) xcd_barrier(bar); } while (0)
    if (EN(0) && IN(0)) { phase_prologue(a, lds); } SEAM(0);
    for (int L = 0; L < DEPTH; ++L) {
        const int base = 1 + 10 * L, jl = L >> 1; const bool even = (L & 1) == 0; unsigned char* ws = opaque_ws(a.ws);
        if (EN(1) && IN(base)) {
            const int N = even ? NE : NO;
            pg8::Gemm g{(const pg8::bf16_t*)(ws + WS_HB), (const pg8::bf16_t*)(ws + (even ? WS_WINE : WS_WINO)) + (size_t)jl * N * D, T, N, D};
            pg8::StaticOrder S; S.init(T, N, (int)gridDim.x, (int)blockIdx.x);
            pg8::EpiProj E{(pg8::bf16_t*)(ws + WS_PROJ), N, N / 256 - 1, (float*)(ws + WS_SMALL)};
            pg8::gemm_phase<pg8::EpiProj, pg8::StaticOrder, false>((PG8_LAS unsigned char*)lds, g, S, E, nullptr);
        }
        SEAM(base);
        if (even) {
            if (EN(2) && IN(base + 1)) phase_chunk_a(a, lds, jl);
            SEAM(base + 1);
            if (EN(3) && IN(base + 2)) phase_scan(a, lds);
            SEAM(base + 2);
            if (EN(4) && IN(base + 3)) phase_chunk_c(a, lds, jl);
            SEAM(base + 3);
        } else {
            if (EN(5) && IN(base + 1)) phase_rope(a, lds);
            SEAM(base + 1);
            if (EN(6) && IN(base + 2)) phase_index(a, lds);
            SEAM(base + 2);
            if (EN(7) && IN(base + 3)) phase_attn(a, lds);
            SEAM(base + 3);
        }
        if (EN(8) && IN(base + 4)) {
            pg8::Gemm g{(const pg8::bf16_t*)(ws + WS_MIXO), (const pg8::bf16_t*)(ws + WS_WOUT) + (size_t)((even ? 0 : 2) + jl) * D * D, T, D, D};
            pg8::StaticOrder S; S.init(T, D, (int)gridDim.x, (int)blockIdx.x);
            pg8::EpiPlain E{(pg8::bf16_t*)(ws + WS_MIX), D, 8};
            pg8::gemm_phase<pg8::EpiPlain, pg8::StaticOrder, false>((PG8_LAS unsigned char*)lds, g, S, E, nullptr);
        }
        SEAM(base + 4);
        if (EN(9) && IN(base + 5)) phase_ln<0>(a, lds, L);
        SEAM(base + 5);
        if (EN(10) && IN(base + 6)) phase_gather(a, lds, L);
        SEAM(base + 6);
        if ((EN(11) && IN(base + 7)) || (EN(12) && IN(base + 8))) {
            const unsigned* cnt = (const unsigned*)(ws + WS_CTL) + CW_CNT + 64 * L;
            pg8::MoeOrder S; { int acc = 0;
#pragma unroll
                for (int e = 0; e < 16; ++e) { S.toff[e] = acc; acc += ((int)__builtin_amdgcn_readfirstlane((int)cnt[e]) + 255) >> 8; } S.toff[16] = acc; }
            S.G = (int)gridDim.x; S.c = (int)blockIdx.x;
            if (EN(11) && IN(base + 7)) { S.ncol = 4;
                pg8::Gemm g{(const pg8::bf16_t*)(ws + WS_XG), (const pg8::bf16_t*)(ws + WS_WGU) + (size_t)L * 16 * 1024 * D, XROWS, 1024, D};
                pg8::EpiGU E{(pg8::bf16_t*)(ws + WS_HMID), (const float*)(ws + WS_GS)};
                pg8::gemm_phase<pg8::EpiGU, pg8::MoeOrder, false>((PG8_LAS unsigned char*)lds, g, S, E, nullptr); }
            SEAM(base + 7);
            if (EN(12) && IN(base + 8)) { S.ncol = 8;
                pg8::Gemm g{(const pg8::bf16_t*)(ws + WS_HMID), (const pg8::bf16_t*)(ws + WS_WDN) + (size_t)L * 16 * D * 512, XROWS, D, 512};
                pg8::EpiPlain E{(pg8::bf16_t*)(ws + WS_Y), D, 8};
                pg8::gemm_phase<pg8::EpiPlain, pg8::MoeOrder, false>((PG8_LAS unsigned char*)lds, g, S, E, nullptr); }
        }
        SEAM(base + 8);
        if (EN(13) && IN(base + 9)) phase_ln<1>(a, lds, L);
        SEAM(base + 9);
    }
#undef IN
#undef SEAM
}

#ifndef N_LAUNCH_MODE
#define N_LAUNCH_MODE 0
#endif
extern "C" void kernel_launch(void* const* d_in, const int* in_sizes, int n_in, void* d_out, int out_size, void* d_ws, size_t ws_size, hipStream_t stream) {
    static int grid = 0;
    if (grid == 0) {
        if (n_in != 22 || out_size != T * D || ws_size < WS_END) { fprintf(stderr, "kernel_launch: unexpected shapes (n_in %d out %d ws %zu need %zu)\n", n_in, out_size, ws_size, (size_t)WS_END); grid = -1; return; }
        int dev = 0, cus = 0, per_cu = 0;
        if (hipGetDevice(&dev) != hipSuccess || hipDeviceGetAttribute(&cus, hipDeviceAttributeMultiprocessorCount, dev) != hipSuccess) { grid = -1; return; }
        if (hipFuncSetAttribute((const void*)fwd, hipFuncAttributeMaxDynamicSharedMemorySize, LDS_BYTES) != hipSuccess) { fprintf(stderr, "kernel_launch: hipFuncSetAttribute failed\n"); grid = -1; return; }
        if (hipOccupancyMaxActiveBlocksPerMultiprocessor(&per_cu, (const void*)fwd, NTHR, LDS_BYTES) != hipSuccess || per_cu < 1) fprintf(stderr, "kernel_launch: occupancy query says %d\n", per_cu);
        (void)hipGetLastError();
        grid = cus;
    }
    if (grid < 0) return;
    (void)hipMemsetAsync((char*)d_ws + WS_CTL, 0, CTL_ZERO_BYTES, stream);
    Args a{};
    a.x = (const float*)d_in[0]; a.pos = (const int*)d_in[1]; a.ab_w_in = (const float*)d_in[2]; a.ab_conv_w = (const float*)d_in[3]; a.ab_igate_b = (const float*)d_in[4]; a.ab_fgate_b = (const float*)d_in[5];
    a.ab_gla_w2 = (const float*)d_in[6]; a.ab_gla_b = (const float*)d_in[7]; a.ab_mnorm = (const float*)d_in[8]; a.ab_gnorm = (const float*)d_in[9]; a.ab_w_out = (const float*)d_in[10];
    a.c_w_in = (const float*)d_in[11]; a.c_w_out = (const float*)d_in[12]; a.router_w = (const float*)d_in[13]; a.router_b = (const float*)d_in[14];
    a.moe_gate = (const float*)d_in[15]; a.moe_up = (const float*)d_in[16]; a.moe_down = (const float*)d_in[17];
    a.ln_mix_g = (const float*)d_in[18]; a.ln_mix_b = (const float*)d_in[19]; a.ln_ffn_g = (const float*)d_in[20]; a.ln_ffn_b = (const float*)d_in[21];
    a.out = (float*)d_out; a.ws = (unsigned char*)d_ws;
#if N_LAUNCH_MODE == 1
    a.ph_lo = 0; a.ph_hi = N_PHASES;
    hipLaunchKernelGGL(fwd, dim3(grid), dim3(NTHR), LDS_BYTES, stream, a);
#else
    for (int p = 0; p < N_PHASES; ++p) { a.ph_lo = p; a.ph_hi = p + 1; hipLaunchKernelGGL(fwd, dim3(grid), dim3(NTHR), LDS_BYTES, stream, a); }
#endif
}
```

```cpp
#include <hip/hip_runtime.h>
#include <cstdio>
#include <cstdint>
namespace pg8 {
#define PG8_LAS __attribute__((address_space(3)))
#define PG8_GAS __attribute__((address_space(1)))
typedef unsigned short bf16_t;
typedef short bf16x8 __attribute__((ext_vector_type(8)));
typedef float f32x4 __attribute__((ext_vector_type(4)));
typedef unsigned u32x4 __attribute__((ext_vector_type(4)));
constexpr int BM = 256, BK = 64, HALF = 128, HTB = HALF * BK * 2  , STAGE_BYTES = 8 * HTB, NXCD = 8, WGM = 8;

__host__ __device__ __forceinline__ int lds_byte(int r, int c) { const int st = (r >> 4) * 2 + (c >> 5), rr = r & 15, cc = c & 31, ob = rr * 64 + cc * 2; return st * 1024 + (ob ^ (((ob >> 9) & 1) << 5)); }
__host__ __device__ __forceinline__ void stage_rc(int b, int& R, int& C) { const int st = b / 1024, sb = b % 1024, swz = sb ^ (((sb >> 9) & 1) << 5); R = (st >> 1) * 16 + swz / 64; C = (st & 1) * 32 + (swz % 64) / 2; }
__host__ __device__ __forceinline__ int perm32(int rho) { const int n = rho >> 4, i = rho & 15; return 8 * (i >> 2) + 4 * n + (i & 3); }

struct Unit { int pm, pn; int e, seg0, cnt; };
struct Gemm { const bf16_t* A; const bf16_t* Bt; int M, N, K; };

struct StaticOrder {
    int nM, nN, nwg, G, c;
    __host__ __device__ void init(int M, int N, int G_, int c_) { nM = M / BM; nN = N / BM; nwg = nM * nN; G = G_; c = c_; }
    __host__ __device__ bool next(int i, Unit& u) const {
        const long L = (long)i * G + c; if (L >= nwg) return false;
        int wgid = (int)L; { const int q = nwg / NXCD, r = nwg % NXCD, xcd = wgid % NXCD, off = wgid / NXCD; wgid = (xcd < r ? xcd * (q + 1) : r * (q + 1) + (xcd - r) * q) + off; }
        const int nig = WGM * nN, gid = wgid / nig, fm = gid * WGM, gsz = (nM - fm) < WGM ? (nM - fm) : WGM;
        u.pm = fm + ((wgid % nig) % gsz); u.pn = (wgid % nig) / gsz; return true;
    }
    __device__ __forceinline__ void a_ready(const Unit&) const {}
    __device__ __forceinline__ void done(const Unit&) const {}
    __device__ __forceinline__ int src_row(const Unit&, int row) const { return row; }
};
__device__ __forceinline__ unsigned cvt_pk_bf16(float lo, float hi) { unsigned r; asm volatile("v_cvt_pk_bf16_f32 %0, %1, %2" : "=v"(r) : "v"(lo), "v"(hi)); return r; }
typedef float f32x2 __attribute__((ext_vector_type(2)));
__device__ __forceinline__ f32x2 gelu_pk(f32x2 v) {
    const f32x2 av = __builtin_elementwise_abs(v), d = av * 0.2316418882f + 1.0f;
    f32x2 t; t.x = __builtin_amdgcn_rcpf(d.x); t.y = __builtin_amdgcn_rcpf(d.y);
    f32x2 q = t * 0.5307027145f + (-0.7265760135f); q = q * t + 0.7107068705f; q = q * t + (-0.142248368f); q = q * t + 0.127414796f; q = q * t;
    const f32x2 s = (v * v) * (-0.72134752044f);
    f32x2 e; e.x = __builtin_amdgcn_exp2f(s.x); e.y = __builtin_amdgcn_exp2f(s.y);
    const f32x2 m = v * (q * e), r = v - m;
    f32x2 o; o.x = v.x < 0.f ? m.x : r.x; o.y = v.y < 0.f ? m.y : r.y; return o;
}


__device__ __forceinline__ u32x4 pack8(const f32x4 v0, const f32x4 v1) { u32x4 w; w.x = cvt_pk_bf16(v0[0], v0[1]); w.y = cvt_pk_bf16(v0[2], v0[3]); w.z = cvt_pk_bf16(v1[0], v1[1]); w.w = cvt_pk_bf16(v1[2], v1[3]); return w; }
struct EpiProj {
    static constexpr bool PERM = true, AFTER_DRAIN = false;
    PG8_GAS bf16_t* O; int ldc; int last_pn; PG8_GAS float* small;
    __device__ __forceinline__ void operator()(const f32x4 (&acc)[2][2][4][2], const Unit& u, int wr, int wc, int fr, int fq) const {
        const int row0 = u.pm * BM + wr * 64 + fr, col0 = u.pn * BM + wc * 32 + 8 * fq; const bool sm = (u.pn == last_pn);
#pragma unroll
        for (int ai = 0; ai < 2; ++ai)
#pragma unroll
            for (int m = 0; m < 4; ++m) { const int row = row0 + ai * HALF + m * 16; PG8_GAS bf16_t* rowp = O + (size_t)row * ldc + col0;
#pragma unroll
                for (int bj = 0; bj < 2; ++bj) *(PG8_GAS u32x4*)(rowp + bj * HALF) = pack8(acc[ai][bj][m][0], acc[ai][bj][m][1]);
                if (sm) { PG8_GAS float* sp = small + (size_t)row * 128 + wc * 32 + 8 * fq; *(PG8_GAS f32x4*)sp = acc[ai][0][m][0]; *(PG8_GAS f32x4*)(sp + 4) = acc[ai][0][m][1]; } }
    }
};
struct EpiPlain {
    static constexpr bool PERM = true, AFTER_DRAIN = false;
    PG8_GAS bf16_t* O; int ldc; int pn_mod;
    __device__ __forceinline__ void operator()(const f32x4 (&acc)[2][2][4][2], const Unit& u, int wr, int wc, int fr, int fq) const {
        const int row0 = u.pm * BM + wr * 64 + fr, col0 = (u.pn % pn_mod) * BM + wc * 32 + 8 * fq;
#pragma unroll
        for (int ai = 0; ai < 2; ++ai)
#pragma unroll
            for (int m = 0; m < 4; ++m) { PG8_GAS bf16_t* rowp = O + (size_t)(row0 + ai * HALF + m * 16) * ldc + col0;
#pragma unroll
                for (int bj = 0; bj < 2; ++bj) *(PG8_GAS u32x4*)(rowp + bj * HALF) = pack8(acc[ai][bj][m][0], acc[ai][bj][m][1]); }
    }
};
typedef unsigned u32x2 __attribute__((ext_vector_type(2)));
struct EpiF8 {
    static constexpr bool PERM = true, AFTER_DRAIN = false;
    PG8_GAS unsigned char* O; int ldc; int pn_mod;
    __device__ __forceinline__ void operator()(const f32x4 (&acc)[2][2][4][2], const Unit& u, int wr, int wc, int fr, int fq) const {
        const int row0 = u.pm * BM + wr * 64 + fr, col0 = (u.pn % pn_mod) * BM + wc * 32 + 8 * fq;
#pragma unroll
        for (int ai = 0; ai < 2; ++ai)
#pragma unroll
            for (int m = 0; m < 4; ++m) { PG8_GAS unsigned char* rowp = O + (size_t)(row0 + ai * HALF + m * 16) * ldc + col0;
#pragma unroll
                for (int bj = 0; bj < 2; ++bj) { const f32x4 v0 = acc[ai][bj][m][0], v1 = acc[ai][bj][m][1];
                    int w0 = __builtin_amdgcn_cvt_pk_fp8_f32(v0[0] * 4.f, v0[1] * 4.f, 0, false); w0 = __builtin_amdgcn_cvt_pk_fp8_f32(v0[2] * 4.f, v0[3] * 4.f, w0, true);
                    int w1 = __builtin_amdgcn_cvt_pk_fp8_f32(v1[0] * 4.f, v1[1] * 4.f, 0, false); w1 = __builtin_amdgcn_cvt_pk_fp8_f32(v1[2] * 4.f, v1[3] * 4.f, w1, true);
                    *(PG8_GAS u32x2*)(rowp + bj * HALF) = (u32x2){(unsigned)w0, (unsigned)w1}; } }
    }
};
struct EpiGU {
    static constexpr bool PERM = true, AFTER_DRAIN = false;
    PG8_GAS bf16_t* H; const PG8_GAS float* glist; int ldl;
    __device__ __forceinline__ void operator()(const f32x4 (&acc)[2][2][4][2], const Unit& u, int wr, int wc, int fr, int fq) const {
        const int row0 = u.pm * BM + wr * 64 + fr, col0 = (u.pn & 3) * 128 + wc * 32 + 8 * fq;
        float gts[2][4];
#pragma unroll
        for (int ai = 0; ai < 2; ++ai)
#pragma unroll
            for (int m = 0; m < 4; ++m) { const int s_ = row0 + ai * HALF + m * 16 - u.seg0; const bool ok = s_ < u.cnt; const float v = glist[(size_t)u.e * ldl + (ok ? s_ : 0)]; gts[ai][m] = ok ? v : 0.f; }
#pragma unroll
        for (int ai = 0; ai < 2; ++ai)
#pragma unroll
            for (int m = 0; m < 4; ++m) { const int row = row0 + ai * HALF + m * 16; const float gt = gts[ai][m]; f32x4 h0, h1;
#pragma unroll
                for (int j = 0; j < 4; ++j) { const float g0 = acc[ai][0][m][0][j], g1 = acc[ai][0][m][1][j];
                    h0[j] = g0 * __builtin_amdgcn_rcpf(1.0f + __expf(-g0)) * acc[ai][1][m][0][j] * gt; h1[j] = g1 * __builtin_amdgcn_rcpf(1.0f + __expf(-g1)) * acc[ai][1][m][1][j] * gt; }
                *(PG8_GAS u32x4*)(H + (size_t)row * 512 + col0) = pack8(h0, h1); }
    }
};
struct MoeOrder {
    int toff[17]; int cnt[16]; int ncol, G, c; const PG8_GAS int* list; int ldl;
    __device__ __forceinline__ bool next(int i, Unit& u) const {
        const int L = i * G + c; if (L >= toff[16] * ncol) return false;
        const int pm = L / ncol, pn = L - pm * ncol; int e = 0;
#pragma unroll
        for (int k = 1; k < 16; ++k) e += (toff[k] <= pm) ? 1 : 0;
        int sg = 0, cn = 0;
#pragma unroll
        for (int k = 0; k < 16; ++k) { sg = (k == e) ? toff[k] * BM : sg; cn = (k == e) ? cnt[k] : cn; }
        u.pm = pm; u.pn = e * ncol + pn; u.e = e; u.seg0 = sg; u.cnt = cn; return true;
    }
    __device__ __forceinline__ void a_ready(const Unit&) const {}
    __device__ __forceinline__ void done(const Unit&) const {}
    __device__ __forceinline__ int src_row(const Unit& u, int row) const { const int s = row - u.seg0; const bool ok = s < u.cnt; const int v = list[(size_t)u.e * ldl + (ok ? s : 0)]; return ok ? v : 0; }
};

template <class Epi, class Sched, bool STAMP = false, bool GATHER = false>
__device__ __forceinline__ void gemm_phase(PG8_LAS unsigned char* lds, const Gemm g, const Sched& S, const Epi& E, unsigned long long* stamps, int wave_s) {
    int l0_, w0_ = wave_s; asm volatile("v_mbcnt_lo_u32_b32 %0, -1, 0\n\tv_mbcnt_hi_u32_b32 %0, -1, %0" : "=&v"(l0_));        asm volatile("" : "+s"(w0_)); const int tid_ = w0_ * 64 + l0_; const int tid = tid_, wid = __builtin_amdgcn_readfirstlane(tid >> 6), lane = tid & 63, wr = wid >> 2, wc = wid & 3, fr = lane & 15, fq = lane >> 4;
    const int K = g.K, nt = K / BK;
    int ts_lo = 0, ts_hi = 0, nts = 0; const unsigned long long rt_entry = STAMP ? (unsigned long long)wall_clock64() : 0ull;
#define PG8_STAMP() do { if (STAMP && wid == 0 && nts < 64) { const unsigned long long _c = (unsigned long long)clock64(); \
        ts_lo = (lane == nts) ? (int)(unsigned)_c : ts_lo; ts_hi = (lane == nts) ? (int)(unsigned)(_c >> 32) : ts_hi; ++nts; } } while (0)
    PG8_STAMP();
    unsigned voffA[2], voffB[2]; int RA[2], CA[2];
#pragma unroll
    for (int i = 0; i < 2; ++i) { int R, C; stage_rc(tid * 16 + i * 8192, R, C); const int Rb = Epi::PERM ? ((R & ~31) + perm32(R & 31)) : R; RA[i] = R; CA[i] = C;
        voffA[i] = (unsigned)(R * K + C) * 2u; voffB[i] = (unsigned)(Rb * K + C) * 2u; }
    unsigned cvo[2][2], nvo[2][2];
#pragma unroll
    for (int hh_ = 0; hh_ < 2; ++hh_)
#pragma unroll
        for (int i = 0; i < 2; ++i) { cvo[hh_][i] = voffA[i]; nvo[hh_][i] = voffA[i]; }
    const size_t hstepA = GATHER ? (size_t)0 : (size_t)HALF * K * 2;
#define PG8_ROWS(u, vo) do { _Pragma("unroll") for (int hh_ = 0; hh_ < 2; ++hh_) _Pragma("unroll") for (int i_ = 0; i_ < 2; ++i_) { \
        const int tok_ = S.src_row((u), (u).pm * BM + HALF * hh_ + RA[i_]); (vo)[hh_][i_] = (unsigned)(tok_ * K + CA[i_]) * 2u; } } while (0)
    const size_t kstep = (size_t)(BK * 2);
    const size_t hstep = (size_t)HALF * K * 2;
    const size_t tstep = 2 * hstep;
    const unsigned ldsw = (unsigned)wid * 1024u;
    const int aoff = lds_byte(wr * 64 + fr, fq * 8), boff = lds_byte(wc * 32 + fr, fq * 8);
#define PG8_SA(b, h) (((b) * 2 + (h)) * HTB)
#define PG8_SB(b, h) ((4 + (b) * 2 + (h)) * HTB)
#define PG8_STAGE(bufoff, gbase, voff) do { _Pragma("unroll") for (int _i = 0; _i < 2; ++_i) \
        __builtin_amdgcn_global_load_lds((const unsigned*)((const char*)(gbase) + (voff)[_i]), (PG8_LAS unsigned*)(lds + (bufoff) + ldsw + _i * 8192), 16, 0, 0); } while (0)
#define PG8_LDA(dst, b, h) do { _Pragma("unroll") for (int m = 0; m < 4; ++m) _Pragma("unroll") for (int k = 0; k < 2; ++k) dst[m][k] = *(const PG8_LAS bf16x8*)(lds + PG8_SA(b, h) + aoff + m * 2048 + k * 1024); } while (0)
#define PG8_LDB(dst, b, h) do { _Pragma("unroll") for (int n = 0; n < 2; ++n) _Pragma("unroll") for (int k = 0; k < 2; ++k) dst[n][k] = *(const PG8_LAS bf16x8*)(lds + PG8_SB(b, h) + boff + n * 2048 + k * 1024); } while (0)
#define PG8_MMA(ai, bj, At, Bt) do { __builtin_amdgcn_s_setprio(1); _Pragma("unroll") for (int m = 0; m < 4; ++m) _Pragma("unroll") for (int n = 0; n < 2; ++n) _Pragma("unroll") for (int k = 0; k < 2; ++k) \
        acc[ai][bj][m][n] = __builtin_amdgcn_mfma_f32_16x16x32_bf16(Bt[n][k], At[m][k], acc[ai][bj][m][n], 0, 0, 0); __builtin_amdgcn_s_setprio(0); } while (0)
#define PG8_WAIT_V(n) asm volatile("s_waitcnt vmcnt(" #n ")" ::: "memory")
#define PG8_WAIT_L(n) asm volatile("s_waitcnt lgkmcnt(" #n ")" ::: "memory")
#define PG8_BAR __builtin_amdgcn_s_barrier()
#define PG8_SCHED __builtin_amdgcn_sched_barrier(0)
    Unit cur, nxt; int ui = 0;
    if (!S.next(0, cur)) return;
    f32x4 acc[2][2][4][2];
#pragma unroll
    for (int a = 0; a < 2; ++a)
#pragma unroll
        for (int b = 0; b < 2; ++b)
#pragma unroll
            for (int m = 0; m < 4; ++m)
#pragma unroll
                for (int n = 0; n < 2; ++n) acc[a][b][m][n] = (f32x4){0.f, 0.f, 0.f, 0.f};
    bf16x8 At[4][2], B0[2][2], B1[2][2];
    const char* cA = (const char*)g.A + (GATHER ? (size_t)0 : (size_t)cur.pm * tstep); const char* cB = (const char*)g.Bt + (size_t)cur.pn * tstep;
    S.a_ready(cur);
    if constexpr (GATHER) { PG8_ROWS(cur, cvo); __builtin_amdgcn_sched_barrier(0); }
    PG8_STAGE(PG8_SB(0, 0), cB, voffB); PG8_STAGE(PG8_SA(0, 0), cA, cvo[0]); PG8_STAGE(PG8_SB(0, 1), cB + hstep, voffB); PG8_STAGE(PG8_SA(0, 1), cA + hstepA, cvo[1]);
    if (wr == 1) PG8_BAR;
    PG8_WAIT_V(4); PG8_BAR;
    PG8_STAGE(PG8_SB(1, 0), cB + kstep, voffB); PG8_STAGE(PG8_SA(1, 0), cA + kstep, cvo[0]); PG8_STAGE(PG8_SB(1, 1), cB + hstep + kstep, voffB);
    PG8_WAIT_V(6); PG8_BAR;
    PG8_STAMP();
    for (;;) {
        const bool has_next = S.next(ui + 1, nxt);
        const char* nA = has_next ? (const char*)g.A + (GATHER ? (size_t)0 : (size_t)nxt.pm * tstep) : cA; const char* nB = has_next ? (const char*)g.Bt + (size_t)nxt.pn * tstep : cB;
        for (int t = 0; t < nt; t += 2) {
            const bool last = (t == nt - 2);
            const char* a1 = cA + (size_t)(t + 1) * kstep;
            const char* a2 = last ? nA : cA + (size_t)(t + 2) * kstep; const char* b2 = last ? nB : cB + (size_t)(t + 2) * kstep;
            const char* a3 = a2 + kstep; const char* b3 = b2 + kstep;
            if (last && has_next) { S.a_ready(nxt); if constexpr (GATHER) PG8_ROWS(nxt, nvo); }
            const bool usen = last && has_next;
#define PG8_VO2(hh_) (usen ? nvo[hh_] : cvo[hh_])
            PG8_LDB(B0, 0, 0); PG8_SCHED; PG8_LDA(At, 0, 0); PG8_STAGE(PG8_SA(1, 1), a1 + hstepA, cvo[1]);
            PG8_WAIT_L(8); PG8_BAR; PG8_WAIT_L(0); PG8_MMA(0, 0, At, B0); PG8_BAR; PG8_SCHED;
            PG8_LDB(B1, 0, 1); PG8_STAGE(PG8_SB(0, 0), b2, voffB);
            PG8_BAR; PG8_WAIT_L(0); PG8_MMA(0, 1, At, B1); PG8_BAR;
            PG8_LDA(At, 0, 1); PG8_STAGE(PG8_SA(0, 0), a2, PG8_VO2(0));
            PG8_BAR; PG8_WAIT_L(0); PG8_MMA(1, 0, At, B0); PG8_BAR; PG8_SCHED;
            PG8_STAGE(PG8_SB(0, 1), b2 + hstep, voffB);
            PG8_WAIT_V(6); PG8_BAR; PG8_MMA(1, 1, At, B1); PG8_BAR;
            PG8_LDB(B0, 1, 0); PG8_SCHED; PG8_LDA(At, 1, 0); PG8_STAGE(PG8_SA(0, 1), a2 + hstepA, PG8_VO2(1));
            PG8_WAIT_L(8); PG8_BAR; PG8_WAIT_L(0); PG8_MMA(0, 0, At, B0); PG8_BAR; PG8_SCHED;
            PG8_LDB(B1, 1, 1); PG8_STAGE(PG8_SB(1, 0), b3, voffB);
            PG8_BAR; PG8_WAIT_L(0); PG8_MMA(0, 1, At, B1); PG8_BAR;
            PG8_LDA(At, 1, 1); PG8_STAGE(PG8_SA(1, 0), a3, PG8_VO2(0));
            PG8_BAR; PG8_WAIT_L(0); PG8_MMA(1, 0, At, B0); PG8_BAR; PG8_SCHED;
            PG8_STAGE(PG8_SB(1, 1), b3 + hstep, voffB);
            PG8_WAIT_V(6); PG8_BAR; PG8_MMA(1, 1, At, B1); PG8_BAR;
        }
        PG8_STAMP();
        if constexpr (!Epi::AFTER_DRAIN) { int le_; asm volatile("v_mbcnt_lo_u32_b32 %0, -1, 0\n\tv_mbcnt_hi_u32_b32 %0, -1, %0" : "=&v"(le_)); E(acc, cur, wr, wc, le_ & 15, le_ >> 4); S.done(cur); }
        PG8_STAMP();
        if (!has_next) break;
#pragma unroll
        for (int a = 0; a < 2; ++a)
#pragma unroll
            for (int b = 0; b < 2; ++b)
#pragma unroll
                for (int m = 0; m < 4; ++m)
#pragma unroll
                    for (int n = 0; n < 2; ++n) acc[a][b][m][n] = (f32x4){0.f, 0.f, 0.f, 0.f};
        cur = nxt; cA = nA; cB = nB; ++ui;
        if constexpr (GATHER) {
#pragma unroll
            for (int hh_ = 0; hh_ < 2; ++hh_)
#pragma unroll
                for (int i = 0; i < 2; ++i) cvo[hh_][i] = nvo[hh_][i]; }
    }
    PG8_WAIT_V(0);
    if (wr == 0) PG8_BAR;
    PG8_BAR;
    if constexpr (Epi::AFTER_DRAIN) { E.fused(acc, cur, wr, wc, fr, fq, lds, wid, lane); S.done(cur); }
    PG8_STAMP();
    if (STAMP && wid == 0) { stamps[lane] = lane < nts ? (((unsigned long long)(unsigned)ts_hi << 32) | (unsigned)ts_lo) : 0ull;
        if (lane == 62) stamps[62] = rt_entry; if (lane == 63) stamps[63] = (unsigned long long)wall_clock64(); }
#undef PG8_STAMP
#undef PG8_SA
#undef PG8_SB
#undef PG8_STAGE
#undef PG8_ROWS
#undef PG8_VO2
#undef PG8_LDA
#undef PG8_LDB
#undef PG8_MMA
#undef PG8_WAIT_V
#undef PG8_WAIT_L
#undef PG8_BAR
#undef PG8_SCHED
}
}

constexpr int T = 16384, D = 2048, DEPTH = 4;
constexpr int NE = 6400, NO = 4352;
constexpr float ALPHA = 1.6817928305074292f;
constexpr float LN_EPS = 1e-5f, HN_EPS = 1e-6f;
constexpr int NWAVES = 8, NTHR = 512;
constexpr int XROWS = 2 * T + 4096;

constexpr int EC_MQ = 0, EC_MK = 512, EC_MV = 1024, EC_MO = 2048, EC_GQ = 3072, EC_GK = 3584, EC_GV = 4096, EC_GR = 5120;
constexpr int OC_Q = 0, OC_K = 2048, OC_V = 2560, OC_QI = 3072;

constexpr size_t MiB = 1u << 20;
constexpr size_t WS_CTL = 0, CTL_ZERO_BYTES = 1 * MiB;
constexpr size_t WS_WINE = 2 * MiB, WS_WINO = 52 * MiB, WS_WOUT = 86 * MiB, WS_WGU = 118 * MiB, WS_WDN = 374 * MiB;
constexpr size_t WS_HB = 502 * MiB, WS_SEL = 566 * MiB, WS_ROPE = 574 * MiB, WS_KI = 576 * MiB, WS_TOK = 578 * MiB, WS_LIST = 579 * MiB, WS_GLIST = 580 * MiB, WS_GS = 581 * MiB;
constexpr size_t WS_MST = 582 * MiB, WS_MPREV = WS_MST + 64 * 1024, WS_NST = 583 * MiB, WS_LAL = 584 * MiB;
constexpr size_t WS_R = 586 * MiB;
constexpr size_t WS_PROJ = WS_R, WS_SMALL = WS_R + 200 * MiB, WS_MIXO = WS_R + 208 * MiB, WS_MIX = WS_R + 272 * MiB, WS_STATES = WS_R + 336 * MiB, WS_QKC = WS_R + 464 * MiB, WS_LA = WS_R + 496 * MiB;
constexpr size_t WS_XG = WS_R, WS_HMID = WS_R + 144 * MiB, WS_Y = WS_R + 180 * MiB;
constexpr size_t WS_END = WS_R + 528 * MiB;
static_assert(WS_Y + (size_t)XROWS * D * 2 <= WS_END && WS_HMID + (size_t)XROWS * 512 * 2 <= WS_Y && WS_XG + (size_t)XROWS * D * 2 <= WS_HMID, "moe overlay");
constexpr int CW_BAR = 4096, CW_CNT = 8192;

constexpr int RING_BYTES = 131072, LDSCTL_OFF = RING_BYTES, LDS_BYTES = 163840;

#define LAS __attribute__((address_space(3)))
#define GAS __attribute__((address_space(1)))
typedef unsigned short bf16;
typedef unsigned v4u __attribute__((ext_vector_type(4)));
typedef unsigned v2u __attribute__((ext_vector_type(2)));
typedef float f32x4 __attribute__((ext_vector_type(4)));
typedef float f2v __attribute__((ext_vector_type(2)));
typedef int i4v __attribute__((ext_vector_type(4)));
typedef float f32x16 __attribute__((ext_vector_type(16)));
typedef short bf16x8 __attribute__((ext_vector_type(8)));
#define LDS_WAIT() asm volatile("s_waitcnt lgkmcnt(0)" ::: "memory")
__device__ __forceinline__ float bf2f(unsigned b) { return __uint_as_float(b << 16); }
typedef __bf16 bf2_t __attribute__((ext_vector_type(2)));
__device__ __forceinline__ unsigned f2bf(float f) { return (unsigned)__builtin_bit_cast(unsigned short, (__bf16)f); }
__device__ __forceinline__ unsigned pk2(float lo, float hi) { bf2_t v; v[0] = (__bf16)lo; v[1] = (__bf16)hi; return __builtin_bit_cast(unsigned, v); }
__device__ __forceinline__ float lo16(unsigned w) { return __uint_as_float(w << 16); }
__device__ __forceinline__ float hi16(unsigned w) { return __uint_as_float(w & 0xffff0000u); }
__device__ __forceinline__ float sigmoidf_(float x) { return __builtin_amdgcn_rcpf(1.0f + __expf(-x)); }
__device__ __forceinline__ float logsigmoidf_(float x) { return fminf(x, 0.0f) - __logf(1.0f + __expf(-fabsf(x))); }
__device__ __forceinline__ float wave_sum(float v) {
#pragma unroll
    for (int o = 1; o < 64; o <<= 1) v += __shfl_xor(v, o);
    return v;
}
__device__ __forceinline__ float wave_max(float v) {
#pragma unroll
    for (int o = 1; o < 64; o <<= 1) v = fmaxf(v, __shfl_xor(v, o));
    return v;
}

#define XB_TMO      128
#define XB_XCNT(j)  (256  + 64 * (j))
#define XB_XSUB(j)  (1280 + 64 * (j))
#define XB_XGEN(j)  (2304 + 64 * (j))
#define XB_TOP      3328
#define XB_TOPGEN   3392
#define XCD_BAR_WORDS 3456
#define XB_SPIN_CAP (1u << 24)
__device__ __forceinline__ unsigned xb_ld(GAS unsigned* p)              { return __hip_atomic_load(p, __ATOMIC_RELAXED, __HIP_MEMORY_SCOPE_AGENT); }
__device__ __forceinline__ unsigned xb_add(GAS unsigned* p, unsigned v) { return __hip_atomic_fetch_add(p, v, __ATOMIC_RELAXED, __HIP_MEMORY_SCOPE_AGENT); }
__device__ __forceinline__ unsigned xb_xcc_id() { return (unsigned)__builtin_amdgcn_s_getreg((3 << 11) | 20) & 0xFu; }
#define XB_SPIN(cond, bar) do { unsigned _sp = 0; while (cond) { __builtin_amdgcn_s_sleep(1); \
    if ((++_sp & 255u) == 0u) { if (xb_ld(&(bar)[XB_TMO])) break; if (_sp > XB_SPIN_CAP) { xb_add(&(bar)[XB_TMO], 1u); break; } } } } while (0)
struct XcdBarrier { GAS unsigned* bar; unsigned x; volatile LAS unsigned* st; };
__device__ __forceinline__ XcdBarrier xcd_barrier_post(GAS unsigned* bar, volatile LAS unsigned* st, bool leader) {
    XcdBarrier b; b.bar = bar; b.x = xb_xcc_id(); b.st = st;
    if (leader) (void)xb_add(&bar[XB_XCNT(b.x)], 1u);
    return b;
}
__device__ __forceinline__ void xcd_barrier_complete(GAS unsigned* bar, unsigned x, unsigned& nloc, unsigned& nx) {
    const unsigned G = gridDim.x * gridDim.y * gridDim.z;
    unsigned sum, cnt, mine, sp = 0u;
    for (;;) {
        sum = 0u; cnt = 0u; mine = 0u;
#pragma unroll
        for (unsigned j = 0; j < 16; ++j) { const unsigned c = xb_ld(&bar[XB_XCNT(j)]); sum += c; cnt += (c > 0u) ? 1u : 0u; mine = (j == x) ? c : mine; }
        if (sum == G) break;
        __builtin_amdgcn_s_sleep(1);
        if ((++sp & 255u) == 0u) { if (xb_ld(&bar[XB_TMO])) break; if (sp > XB_SPIN_CAP) { xb_add(&bar[XB_TMO], 1u); break; } }
    }
    nloc = mine > 0u ? mine : 1u; nx = cnt > 0u ? cnt : 1u;
}
__device__ __forceinline__ void xcd_barrier(const XcdBarrier& b, bool leader) {
    asm volatile("s_waitcnt vmcnt(0)" ::: "memory");
    __syncthreads();
    if (leader) {
        GAS unsigned* bar = b.bar;
        __builtin_amdgcn_s_waitcnt(0);
        unsigned nloc = b.st[0], nx = b.st[1];
        if (nloc == 0u) { xcd_barrier_complete(bar, b.x, nloc, nx); b.st[0] = nloc; b.st[1] = nx; }
        const unsigned old = xb_add(&bar[XB_XSUB(b.x)], 1u);
        const unsigned gen = old / nloc;
        if (old + 1u == (gen + 1u) * nloc) {
            __builtin_amdgcn_fence(__ATOMIC_RELEASE, "agent");
            asm volatile("s_waitcnt vmcnt(0)" ::: "memory");
            const unsigned og = xb_add(&bar[XB_TOP], 1u);
            const unsigned tg = og / nx;
            if (og + 1u == (tg + 1u) * nx) xb_add(&bar[XB_TOPGEN], 1u);
            else XB_SPIN(xb_ld(&bar[XB_TOPGEN]) == tg, bar);
            __builtin_amdgcn_fence(__ATOMIC_ACQUIRE, "agent");
            xb_add(&bar[XB_XGEN(b.x)], 1u);
            asm volatile("s_waitcnt vmcnt(0)" ::: "memory");
        } else {
            XB_SPIN(xb_ld(&bar[XB_XGEN(b.x)]) == gen, bar);
            __builtin_amdgcn_fence(__ATOMIC_ACQUIRE, "agent");
            asm volatile("s_waitcnt vmcnt(0)" ::: "memory");
        }
    }
    __syncthreads();
}

struct Args {
    const float* x; const int* pos; const float* ab_w_in; const float* ab_conv_w; const float* ab_igate_b; const float* ab_fgate_b; const float* ab_gla_w2; const float* ab_gla_b;
    const float* ab_mnorm; const float* ab_gnorm; const float* ab_w_out; const float* c_w_in; const float* c_w_out; const float* router_w; const float* router_b;
    const float* moe_gate; const float* moe_up; const float* moe_down; const float* ln_mix_g; const float* ln_mix_b; const float* ln_ffn_g; const float* ln_ffn_b;
    float* out; unsigned char* ws; int ph_lo, ph_hi;
};
#define CONSTAS __attribute__((address_space(4)))
typedef const CONSTAS Args* ArgsP;
__device__ __forceinline__ ArgsP opaque_args() { unsigned long long v = (unsigned long long)__builtin_amdgcn_kernarg_segment_ptr(); asm volatile("" : "+s"(v)); return (ArgsP)v; }
struct Ctx { LAS unsigned char* lds; int tid, lane, wave; };
struct LW { LAS unsigned char* p; int w; };
__device__ __forceinline__ int lane_id() { int l_; asm volatile("v_mbcnt_lo_u32_b32 %0, -1, 0\n\tv_mbcnt_hi_u32_b32 %0, -1, %0" : "=&v"(l_)); return l_; }
__device__ __forceinline__ Ctx make_ctx(LW lds) { Ctx c; int l = lane_id(), w = lds.w; asm volatile("" : "+v"(l)); asm volatile("" : "+s"(w)); c.lds = lds.p; c.tid = w * 64 + l; c.lane = l; c.wave = w; return c; }
__device__ __forceinline__ GAS unsigned char* opaque_ws(const void* p) { unsigned long long v = (unsigned long long)p; asm volatile("" : "+s"(v)); return (GAS unsigned char*)v; }

__device__ __forceinline__ void xpose_item(const GAS float* W, int ldw, int c0, int k0, GAS bf16* dst, int Kd, LAS float* scr, int lane) {
#pragma unroll 8
    for (int i = 0; i < 32; ++i) { const int kk = 2 * i + (lane >> 5); scr[kk * 33 + (lane & 31)] = W[(size_t)(k0 + kk) * ldw + c0 + (lane & 31)]; }
    LDS_WAIT();
    const int c = lane & 7;
#pragma unroll
    for (int j = 0; j < 4; ++j) { const int n = (lane >> 3) + 8 * j; const LAS float* s = scr + (8 * c) * 33 + n;
        v4u o; o.x = pk2(s[0 * 33], s[1 * 33]); o.y = pk2(s[2 * 33], s[3 * 33]); o.z = pk2(s[4 * 33], s[5 * 33]); o.w = pk2(s[6 * 33], s[7 * 33]);
        *(GAS v4u*)(dst + (size_t)n * Kd + k0 + 8 * c) = o; }
    LDS_WAIT();
}
__device__ __forceinline__ void phase_prologue(ArgsP ap, LW lds_) {
    const CONSTAS Args& a = *ap; const Ctx c = make_ctx(lds_); GAS unsigned char* ws = opaque_ws(a.ws);
    GAS bf16* WINE = (GAS bf16*)(ws + WS_WINE); GAS bf16* WINO = (GAS bf16*)(ws + WS_WINO); GAS bf16* WOUT = (GAS bf16*)(ws + WS_WOUT); GAS bf16* WGU = (GAS bf16*)(ws + WS_WGU); GAS bf16* WDN = (GAS bf16*)(ws + WS_WDN);
    LAS float* scr = (LAS float*)(c.lds + c.wave * 16384);
    const int gw = blockIdx.x * NWAVES + c.wave, NGW = gridDim.x * NWAVES;
    constexpr int I0 = 65536, I1 = 32768, I2 = 8192, I3 = 2 * 6144, I4 = 2 * 4160, NIT = I0 + I1 + I2 + I3 + I4;
    for (int it = gw; it < NIT; it += NGW) {
        int r = it;
        if (r < I0) { const int nb = r & 3, kb = (r >> 2) & 31, pn = (r >> 7) & 3, which = (r >> 9) & 1, le = r >> 10;
            const GAS float* src = (which ? ((const GAS float*)a.moe_up) : ((const GAS float*)a.moe_gate)) + (size_t)le * 2048 * 512;
            xpose_item(src, 512, 128 * pn + 32 * nb, 64 * kb, WGU + ((size_t)le * 1024 + 256 * pn + 128 * which + 32 * nb) * 2048, 2048, scr, c.lane); continue; }
        r -= I0;
        if (r < I1) { const int nb = r & 63, kb = (r >> 6) & 7, le = r >> 9;
            xpose_item(((const GAS float*)a.moe_down) + (size_t)le * 512 * 2048, 2048, 32 * nb, 64 * kb, WDN + ((size_t)le * 2048 + 32 * nb) * 512, 512, scr, c.lane); continue; }
        r -= I1;
        if (r < I2) { const int nb = r & 63, kb = (r >> 6) & 31, mat = r >> 11;
            const GAS float* src = mat < 2 ? ((const GAS float*)a.ab_w_out) + (size_t)mat * 2048 * 2048 : ((const GAS float*)a.c_w_out) + (size_t)(mat - 2) * 2048 * 2048;
            xpose_item(src, 2048, 32 * nb, 64 * kb, WOUT + (size_t)mat * 2048 * 2048 + (size_t)(32 * nb) * 2048, 2048, scr, c.lane); continue; }
        r -= I2;
        if (r < I3) { const int j = r / 6144, q = r % 6144, cb = q % 192, kb = q / 192, d = 32 * cb, sc = d < 2048 ? d : (d < 5120 ? d + 8 : d + 24);
            xpose_item(((const GAS float*)a.ab_w_in) + (size_t)j * 2048 * 6168, 6168, sc, 64 * kb, WINE + (size_t)j * NE * 2048 + (size_t)d * 2048, 2048, scr, c.lane); continue; }
        r -= I3;
        { const int j = r / 4160, q = r % 4160, cb = q % 130, kb = q / 130, d = 32 * cb;
            xpose_item(((const GAS float*)a.c_w_in) + (size_t)j * 2048 * 4176, 4176, d, 64 * kb, WINO + (size_t)j * NO * 2048 + (size_t)d * 2048, 2048, scr, c.lane); }
    }
    const int gt = blockIdx.x * NTHR + c.tid, NT = gridDim.x * NTHR;
    for (int i = gt; i < 2 * 24 * 2048; i += NT) { const int j = i / (24 * 2048), q = i % (24 * 2048), r = q / 2048, k = q % 2048, sc = r < 8 ? 2048 + r : 5128 + (r - 8);
        WINE[(size_t)j * NE * 2048 + (size_t)(6144 + r) * 2048 + k] = (bf16)f2bf(((const GAS float*)a.ab_w_in)[(size_t)j * 2048 * 6168 + (size_t)k * 6168 + sc]); }
    for (int i = gt; i < 2 * 232 * 2048; i += NT) { const int j = i / (232 * 2048), q = i % (232 * 2048); WINE[(size_t)j * NE * 2048 + (size_t)6168 * 2048 + q] = 0; }
    for (int i = gt; i < 2 * 16 * 2048; i += NT) { const int j = i / (16 * 2048), q = i % (16 * 2048), r = q / 2048, k = q % 2048;
        WINO[(size_t)j * NO * 2048 + (size_t)(4160 + r) * 2048 + k] = (bf16)f2bf(((const GAS float*)a.c_w_in)[(size_t)j * 2048 * 4176 + (size_t)k * 4176 + 4160 + r]); }
    for (int i = gt; i < 2 * 176 * 2048; i += NT) { const int j = i / (176 * 2048), q = i % (176 * 2048); WINO[(size_t)j * NO * 2048 + (size_t)4176 * 2048 + q] = 0; }
    { const GAS f32x4* x4 = (const GAS f32x4*)((const GAS float*)a.x); GAS v4u* hb = (GAS v4u*)(ws + WS_HB);
      for (int i = gt; i < T * D / 8; i += NT) { const f32x4 p = x4[2 * i], q = x4[2 * i + 1]; v4u o; o.x = pk2(p[0], p[1]); o.y = pk2(p[2], p[3]); o.z = pk2(q[0], q[1]); o.w = pk2(q[2], q[3]); hb[i] = o; } }
    { GAS f2v* rope = (GAS f2v*)(ws + WS_ROPE);
      for (int i = gt; i < T * 16; i += NT) { const int t = i >> 4, f = i & 15; const float inv = 1.0f / powf(500000.0f, (float)f / 16.0f);
          const double ang = (double)((const GAS int*)a.pos)[t] * (double)inv; rope[i] = (f2v){(float)cos(ang), (float)sin(ang)}; } }
}

template <int MODE> __device__ __forceinline__ void phase_ln(ArgsP ap, LW lds_, int layer) {
    const CONSTAS Args& a = *ap; const Ctx c = make_ctx(lds_); GAS unsigned char* ws = opaque_ws(a.ws);
    GAS bf16* HB = (GAS bf16*)(ws + WS_HB); const GAS bf16* MIX = (const GAS bf16*)(ws + WS_MIX); const GAS unsigned char* Y = (const GAS unsigned char*)(ws + WS_Y);
    GAS unsigned* cnt = (GAS unsigned*)(ws + WS_CTL) + CW_CNT + 64 * layer;
    GAS i4v* tok = (GAS i4v*)(ws + WS_TOK); GAS int* list = (GAS int*)(ws + WS_LIST); GAS float* glist = (GAS float*)(ws + WS_GLIST);
    const GAS float* g = (MODE == 0 ? ((const GAS float*)a.ln_mix_g) : ((const GAS float*)a.ln_ffn_g)) + layer * D; const GAS float* b = (MODE == 0 ? ((const GAS float*)a.ln_mix_b) : ((const GAS float*)a.ln_ffn_b)) + layer * D;
    const int gw = blockIdx.x * NWAVES + c.wave, NGW = gridDim.x * NWAVES, lane = c.lane;
    int soff[16];
    if (MODE == 1) { int acc = 0;
#pragma unroll
        for (int e = 0; e < 16; ++e) { soff[e] = acc; const int ce = (int)__builtin_amdgcn_readfirstlane((int)cnt[e]); acc += (ce + 255) & ~255; } }
    LAS f32x4* LW = (LAS f32x4*)c.lds;
    if (MODE == 0) { for (int idx = c.tid; idx < 8192; idx += NTHR) { const int d = idx >> 2, q = idx & 3, j = d >> 9, l = (d >> 3) & 63, i = d & 7; LW[((j * 8 + i) * 4 + q) * 64 + l] = *(const GAS f32x4*)(((const GAS float*)a.router_w) + (size_t)d * 16 + 4 * q); }
        __syncthreads(); }
    LAS int* rinfo = (LAS int*)(c.lds + 131072); LAS unsigned* lcnt = (LAS unsigned*)(c.lds + 131072 + 2048); LAS unsigned* lbase = lcnt + 16;
    LAS f32x4* GB = (LAS f32x4*)(c.lds + 135168);
    for (int idx = c.tid; idx < 1024; idx += NTHR) { const int l_ = idx & 63, hf = (idx >> 6) & 1, j_ = (idx >> 7) & 3, wh = idx >> 9; GB[idx] = *(const GAS f32x4*)((wh ? b : g) + 512 * j_ + 8 * l_ + 4 * hf); }
    LAS float* RBL = (LAS float*)(c.lds + 151552); if (MODE == 0 && c.tid < 16) RBL[c.tid] = ((const GAS float*)a.router_b)[c.tid];
    __syncthreads();
    const int rows_per_wave = (T + NGW - 1) / NGW;
    for (int k0 = 0; k0 < rows_per_wave; k0 += 8) {
      if (MODE == 0) { __syncthreads(); if (c.tid < 16) lcnt[c.tid] = 0u; __syncthreads(); }
      v4u nh[4], n1[4], n2[4]; i4v tkn = (i4v){0, 0, 0, 0};
#define LN_ISSUE(trow, tkv) do { const int t_ = (trow); if (t_ < T) { const GAS bf16* r1_; const GAS bf16* r2_ = nullptr; \
          if (MODE == 0) r1_ = MIX + (size_t)t_ * D; \
          else { int p0_ = 0, p1_ = 0; _Pragma("unroll") for (int e_ = 0; e_ < 16; ++e_) { if ((tkv).x == e_) p0_ = soff[e_] + (tkv).y; if ((tkv).z == e_) p1_ = soff[e_] + (tkv).w; } \
              r1_ = (const GAS bf16*)(Y + (size_t)p0_ * D); r2_ = (const GAS bf16*)(Y + (size_t)p1_ * D); }        \
          _Pragma("unroll") for (int j_ = 0; j_ < 4; ++j_) { nh[j_] = *(const GAS v4u*)(HB + (size_t)t_ * D + 512 * j_ + 8 * lane); \
              if (MODE == 0) { n1[j_] = *(const GAS v4u*)(r1_ + 512 * j_ + 8 * lane); n2[j_] = (v4u){0u, 0u, 0u, 0u}; } \
              else { const v2u a_ = *(const GAS v2u*)((const GAS unsigned char*)r1_ + 512 * j_ + 8 * lane), b_ = *(const GAS v2u*)((const GAS unsigned char*)r2_ + 512 * j_ + 8 * lane); \
                     n1[j_] = (v4u){a_[0], a_[1], 0u, 0u}; n2[j_] = (v4u){b_[0], b_[1], 0u, 0u}; } } } } while (0)
      { const int tf = gw + k0 * NGW; if (MODE == 1 && tf < T) tkn = tok[tf]; LN_ISSUE(tf, tkn); if (MODE == 1 && tf + NGW < T) tkn = tok[tf + NGW]; }
      for (int kk = 0; kk < 8; ++kk) { const int t = gw + (k0 + kk) * NGW; if (t >= T) continue;
        float v[32];
#pragma unroll
        for (int j = 0; j < 4; ++j) {
            if (MODE == 0) {
#pragma unroll
                for (int i = 0; i < 4; ++i) { v[8 * j + 2 * i] = ALPHA * lo16(nh[j][i]) + lo16(n1[j][i]); v[8 * j + 2 * i + 1] = ALPHA * hi16(nh[j][i]) + hi16(n1[j][i]); }
            } else {
#pragma unroll
                for (int i2 = 0; i2 < 2; ++i2) { const f2v a0_ = __builtin_amdgcn_cvt_pk_f32_fp8((int)n1[j][i2], false), a1_ = __builtin_amdgcn_cvt_pk_f32_fp8((int)n1[j][i2], true);
                    const f2v b0_ = __builtin_amdgcn_cvt_pk_f32_fp8((int)n2[j][i2], false), b1_ = __builtin_amdgcn_cvt_pk_f32_fp8((int)n2[j][i2], true);
                    v[8 * j + 4 * i2] = ALPHA * lo16(nh[j][2 * i2]) + (a0_[0] + b0_[0]) * 0.25f; v[8 * j + 4 * i2 + 1] = ALPHA * hi16(nh[j][2 * i2]) + (a0_[1] + b0_[1]) * 0.25f;
                    v[8 * j + 4 * i2 + 2] = ALPHA * lo16(nh[j][2 * i2 + 1]) + (a1_[0] + b1_[0]) * 0.25f; v[8 * j + 4 * i2 + 3] = ALPHA * hi16(nh[j][2 * i2 + 1]) + (a1_[1] + b1_[1]) * 0.25f; }
            }
        }
        if (kk + 1 < 8) { LN_ISSUE(t + NGW, tkn); if (MODE == 1 && kk + 2 < 8 && t + 2 * NGW < T) tkn = tok[t + 2 * NGW]; }
        float s = 0.f;
#pragma unroll
        for (int i = 0; i < 32; ++i) s += v[i];
        const float mean = wave_sum(s) * (1.0f / D); float s2 = 0.f;
#pragma unroll
        for (int i = 0; i < 32; ++i) { v[i] -= mean; s2 += v[i] * v[i]; }
        const float rstd = 1.0f / sqrtf(wave_sum(s2) * (1.0f / D) + LN_EPS);
#pragma unroll
        for (int j = 0; j < 4; ++j) { const f32x4 g0 = GB[(j * 2) * 64 + lane], g1 = GB[(j * 2 + 1) * 64 + lane], b0 = GB[512 + (j * 2) * 64 + lane], b1 = GB[512 + (j * 2 + 1) * 64 + lane];
#pragma unroll
            for (int i = 0; i < 4; ++i) { v[8 * j + i] = v[8 * j + i] * rstd * g0[i] + b0[i]; v[8 * j + 4 + i] = v[8 * j + 4 + i] * rstd * g1[i] + b1[i]; } }
        if (MODE == 1 && layer == DEPTH - 1) {
#pragma unroll
            for (int j = 0; j < 4; ++j) { GAS float* o = ((GAS float*)a.out) + (size_t)t * D + 512 * j + 8 * lane; *(GAS f32x4*)o = (f32x4){v[8 * j], v[8 * j + 1], v[8 * j + 2], v[8 * j + 3]}; *(GAS f32x4*)(o + 4) = (f32x4){v[8 * j + 4], v[8 * j + 5], v[8 * j + 6], v[8 * j + 7]}; }
        } else {
#pragma unroll
            for (int j = 0; j < 4; ++j) { v4u o; o.x = pk2(v[8 * j], v[8 * j + 1]); o.y = pk2(v[8 * j + 2], v[8 * j + 3]); o.z = pk2(v[8 * j + 4], v[8 * j + 5]); o.w = pk2(v[8 * j + 6], v[8 * j + 7]);
                *(GAS v4u*)(HB + (size_t)t * D + 512 * j + 8 * lane) = o; }
        }
        if (MODE == 0) {
            float lg[16];
#pragma unroll
            for (int e = 0; e < 16; ++e) lg[e] = 0.f;
#pragma unroll
            for (int j = 0; j < 4; ++j)
#pragma unroll
                for (int i = 0; i < 8; ++i) { const float y = v[8 * j + i]; if ((i & 1) == 0) asm volatile("" ::: "memory");
#pragma unroll
                    for (int q = 0; q < 4; ++q) { const f32x4 w = LW[((j * 8 + i) * 4 + q) * 64 + lane]; lg[4 * q] += y * w[0]; lg[4 * q + 1] += y * w[1]; lg[4 * q + 2] += y * w[2]; lg[4 * q + 3] += y * w[3]; } }
            float aff[16], sel[16];
#pragma unroll
            for (int e = 0; e < 16; ++e) { aff[e] = sigmoidf_(wave_sum(lg[e])); sel[e] = aff[e] + RBL[e]; }
            int gbest = 0; float gsbest = -1e30f;
#pragma unroll
            for (int gi = 0; gi < 4; ++gi) { float m1 = -1e30f, m2 = -1e30f;
#pragma unroll
                for (int k = 0; k < 4; ++k) { const float x = sel[4 * gi + k]; if (x > m1) { m2 = m1; m1 = x; } else if (x > m2) m2 = x; }
                const float gs = m1 + m2; if (gs > gsbest) { gsbest = gs; gbest = gi; } }
            float s0 = -1e30f, s1 = -1e30f; int l0 = 0, l1 = 0; float a0 = 0.f, a1 = 0.f;
#pragma unroll
            for (int gi = 0; gi < 4; ++gi) if (gi == gbest) {
#pragma unroll
                for (int k = 0; k < 4; ++k) { const float x = sel[4 * gi + k]; if (x > s0) { s1 = s0; l1 = l0; a1 = a0; s0 = x; l0 = k; a0 = aff[4 * gi + k]; } else if (x > s1) { s1 = x; l1 = k; a1 = aff[4 * gi + k]; } } }
            const int e0 = 4 * gbest + l0, e1 = 4 * gbest + l1; const float inv = 1.0f / (a0 + a1);
            if (lane == 0) { const int l0s = (int)__hip_atomic_fetch_add(lcnt + e0, 1u, __ATOMIC_RELAXED, __HIP_MEMORY_SCOPE_WORKGROUP), l1s = (int)__hip_atomic_fetch_add(lcnt + e1, 1u, __ATOMIC_RELAXED, __HIP_MEMORY_SCOPE_WORKGROUP);
                LAS int* ri = rinfo + (c.wave * 8 + kk) * 8; ri[0] = e0; ri[1] = l0s; ri[2] = e1; ri[3] = l1s; ri[4] = (int)__float_as_uint(a0 * inv); ri[5] = (int)__float_as_uint(a1 * inv); }
        }
      }
      if (MODE == 0) {
          __syncthreads(); if (c.tid < 16) lbase[c.tid] = xb_add(&cnt[c.tid], lcnt[c.tid]); __syncthreads();
          if (c.tid < 64) { const int w = c.tid >> 3, kk = c.tid & 7, t = (int)(blockIdx.x * NWAVES + w) + (k0 + kk) * NGW;
              if (t < T) { const LAS int* ri = rinfo + c.tid * 8; const int e0 = ri[0], e1 = ri[2], s0 = (int)lbase[e0] + ri[1], s1 = (int)lbase[e1] + ri[3];
                  list[e0 * T + s0] = t; glist[e0 * T + s0] = __uint_as_float((unsigned)ri[4]); list[e1 * T + s1] = t; glist[e1 * T + s1] = __uint_as_float((unsigned)ri[5]); tok[t] = (i4v){e0, s0, e1, s1}; } } }
    }
}

__device__ __forceinline__ void phase_gather(ArgsP ap, LW lds_, int layer) {
    const CONSTAS Args& a = *ap; const Ctx c = make_ctx(lds_); GAS unsigned char* ws = opaque_ws(a.ws); const GAS bf16* HB = (const GAS bf16*)(ws + WS_HB); GAS bf16* XG = (GAS bf16*)(ws + WS_XG); GAS float* GS = (GAS float*)(ws + WS_GS);
    const GAS unsigned* cnt = (const GAS unsigned*)(ws + WS_CTL) + CW_CNT + 64 * layer; const GAS int* list = (const GAS int*)(ws + WS_LIST); const GAS float* glist = (const GAS float*)(ws + WS_GLIST);
    int soff[17], cn[16]; { int acc = 0;
#pragma unroll
        for (int e = 0; e < 16; ++e) { soff[e] = acc; cn[e] = (int)__builtin_amdgcn_readfirstlane((int)cnt[e]); acc += (cn[e] + 255) & ~255; } soff[16] = acc; }
    const int gw = blockIdx.x * NWAVES + c.wave, NGW = gridDim.x * NWAVES, lane = c.lane;
    for (int p = gw; p < soff[16]; p += NGW) {
        int e = 0, so = 0, ce = 0;
#pragma unroll
        for (int k = 0; k < 16; ++k) if (soff[k] <= p) { e = k; so = soff[k]; ce = cn[k]; }
        const int s = p - so; GAS v4u* dst = (GAS v4u*)(XG + (size_t)p * D);
        if (s < ce) { const int tkn = list[e * T + s]; const GAS v4u* src = (const GAS v4u*)(HB + (size_t)tkn * D);
#pragma unroll
            for (int j = 0; j < 4; ++j) dst[64 * j + lane] = src[64 * j + lane];
            if (lane == 0) GS[p] = glist[e * T + s]; }
        else {
#pragma unroll
            for (int j = 0; j < 4; ++j) dst[64 * j + lane] = (v4u){0u, 0u, 0u, 0u};
            if (lane == 0) GS[p] = 0.f; }
    }
}

#define MFMA32(a, b, c) __builtin_amdgcn_mfma_f32_32x32x16_bf16((a), (b), (c), 0, 0, 0)
__device__ __forceinline__ bf16x8 frag_v(const LAS bf16* p) { return *(const LAS bf16x8*)p; }
__device__ __forceinline__ bf16x8 frag_s(const LAS bf16* p, int stride) { bf16x8 r;
#pragma unroll
    for (int j = 0; j < 8; ++j) r[j] = (short)p[j * stride];
    return r; }
typedef short s16x4 __attribute__((ext_vector_type(4)));
__device__ __forceinline__ bf16x8 frag_tr(const LAS bf16* base, int pitch, int k0, int rc0, int lane) {
    const int g = lane >> 4, i16 = lane & 15; const LAS bf16* a0 = base + (k0 + 8 * (g >> 1) + (i16 >> 2)) * pitch + rc0 + 16 * (g & 1) + 4 * (i16 & 3);
    const s16x4 r0 = __builtin_amdgcn_ds_read_tr16_b64_v4i16((LAS s16x4*)a0), r1 = __builtin_amdgcn_ds_read_tr16_b64_v4i16((LAS s16x4*)(a0 + 4 * pitch));
    return __builtin_shufflevector(r0, r1, 0, 1, 2, 3, 4, 5, 6, 7); }
__device__ __forceinline__ int drow(int reg, int h) { return (reg & 3) + 8 * (reg >> 2) + 4 * h; }
__device__ __forceinline__ f32x16 zero16() { f32x16 z;
#pragma unroll
    for (int i = 0; i < 16; ++i) z[i] = 0.f;
    return z; }

constexpr int LQ = 136, LV = 264, LP = 72, LKW = 144, LVV = 272;
constexpr float RSQ_DK = 0.08838834764831845f;
__device__ __forceinline__ void phase_chunk_a(ArgsP ap, LW lds_, int jl) {
    const CONSTAS Args& a = *ap; const Ctx c = make_ctx(lds_); GAS unsigned char* ws = opaque_ws(a.ws); const GAS bf16* PROJ = (const GAS bf16*)(ws + WS_PROJ); const GAS float* SMALL = (const GAS float*)(ws + WS_SMALL);
    GAS bf16* ST = (GAS bf16*)(ws + WS_STATES); GAS bf16* QKC = (GAS bf16*)(ws + WS_QKC); GAS float* LA = (GAS float*)(ws + WS_LA);
    GAS float* MST = (GAS float*)(ws + WS_MST); GAS float* NST = (GAS float*)(ws + WS_NST); GAS float* LAL = (GAS float*)(ws + WS_LAL);
    LAS bf16* kw = (LAS bf16*)(c.lds); LAS bf16* vv = (LAS bf16*)(c.lds + 18432); LAS float* wkv = (LAS float*)(c.lds + 53248); LAS float* laf = (LAS float*)(c.lds + 53504);
    const int tid = c.tid, lane = c.lane, wave = c.wave, r = lane & 31, h = lane >> 5;
    for (int u = blockIdx.x; u < 2048; u += gridDim.x) {
        const int n = u >> 3, hh = (u + (u >> 8)) & 7, t0 = n * 64;
        __syncthreads();
        if (hh < 4) {
            if (wave == 0) {
                const GAS float* sm = SMALL + (size_t)(t0 + lane) * 128;
                const float ig = sm[hh] + ((const GAS float*)a.ab_igate_b)[jl * 4 + hh]; const float lf = logsigmoidf_(sm[4 + hh] + ((const GAS float*)a.ab_fgate_b)[jl * 4 + hh]);
                float b = lf;
#pragma unroll
                for (int o = 1; o < 64; o <<= 1) { const float y = __shfl_up(b, o); if (lane >= o) b += y; }
                const float blast = __shfl(b, 63); const float av = blast - b + ig; const float ml = wave_max(av);
                wkv[lane] = __expf(av - ml);
                if (lane == 0) { MST[(n * 4 + hh) * 2] = blast; MST[(n * 4 + hh) * 2 + 1] = ml; }
            }
            __syncthreads();
            for (int it = tid; it < 2048; it += NTHR) {
                const int which = it >> 10, jj = (it >> 4) & 63, c8 = it & 15, t = t0 + jj;
                const int col = (which ? EC_MK : EC_MQ) + hh * 128 + 8 * c8, cch = which * 512 + hh * 128 + 8 * c8;
                float acc[8];
#pragma unroll
                for (int i = 0; i < 8; ++i) acc[i] = 0.f;
#pragma unroll
                for (int w = 0; w < 4; ++w) { const int tt = t - 3 + w; if (tt >= 0) {
                    const v4u xv = *(const GAS v4u*)(PROJ + (size_t)tt * NE + col); const GAS float* cw = ((const GAS float*)a.ab_conv_w) + (size_t)(jl * 4 + w) * 1024 + cch; const f32x4 c0 = *(const GAS f32x4*)cw, c1 = *(const GAS f32x4*)(cw + 4);
                    acc[0] += lo16(xv[0]) * c0[0]; acc[1] += hi16(xv[0]) * c0[1]; acc[2] += lo16(xv[1]) * c0[2]; acc[3] += hi16(xv[1]) * c0[3];
                    acc[4] += lo16(xv[2]) * c1[0]; acc[5] += hi16(xv[2]) * c1[1]; acc[6] += lo16(xv[3]) * c1[2]; acc[7] += hi16(xv[3]) * c1[3]; } }
#pragma unroll
                for (int i = 0; i < 8; ++i) acc[i] = acc[i] * sigmoidf_(acc[i]);
                if (which == 0) { v4u o; o.x = pk2(acc[0], acc[1]); o.y = pk2(acc[2], acc[3]); o.z = pk2(acc[4], acc[5]); o.w = pk2(acc[6], acc[7]);
                    *(GAS v4u*)(QKC + (size_t)t * 1024 + hh * 128 + 8 * c8) = o; }
                else {
#pragma unroll
                    for (int i = 0; i < 8; ++i) acc[i] *= RSQ_DK;
                    v4u o; o.x = pk2(acc[0], acc[1]); o.y = pk2(acc[2], acc[3]); o.z = pk2(acc[4], acc[5]); o.w = pk2(acc[6], acc[7]);
                    *(GAS v4u*)(QKC + (size_t)t * 1024 + 512 + hh * 128 + 8 * c8) = o;
                    const float wj = wkv[jj]; v4u p; p.x = pk2(acc[0] * wj, acc[1] * wj); p.y = pk2(acc[2] * wj, acc[3] * wj); p.z = pk2(acc[4] * wj, acc[5] * wj); p.w = pk2(acc[6] * wj, acc[7] * wj);
                    *(LAS v4u*)(kw + jj * LKW + 8 * c8) = p; }
            }
        } else {
            const int g = hh - 4;
            { const int d = tid & 127, jq = tid >> 7; float w2r[16];
#pragma unroll
              for (int q = 0; q < 16; ++q) w2r[q] = ((const GAS float*)a.ab_gla_w2)[(size_t)(jl * 16 + q) * 512 + g * 128 + d];
              const float gb = ((const GAS float*)a.ab_gla_b)[jl * 512 + g * 128 + d];
              for (int jj = jq * 16; jj < jq * 16 + 16; ++jj) { const GAS float* sm = SMALL + (size_t)(t0 + jj) * 128 + 8; float s = gb;
#pragma unroll
                  for (int q = 0; q < 16; ++q) s += sm[q] * w2r[q];
                  laf[jj * 128 + d] = logsigmoidf_(s) * (1.0f / 16.0f); } }
            __syncthreads();
            if (tid < 128) { float run = 0.f;
                for (int jj = 0; jj < 64; ++jj) { run += laf[jj * 128 + tid]; laf[jj * 128 + tid] = run; LA[(size_t)(t0 + jj) * 512 + g * 128 + tid] = run; }
                LAL[(n * 4 + g) * 128 + tid] = run; }
            __syncthreads();
            for (int it = tid; it < 1024; it += NTHR) { const int jj = it >> 4, c8 = it & 15;
                const v4u kv = *(const GAS v4u*)(PROJ + (size_t)(t0 + jj) * NE + EC_GK + g * 128 + 8 * c8); float kf[8];
#pragma unroll
                for (int i = 0; i < 4; ++i) { kf[2 * i] = lo16(kv[i]); kf[2 * i + 1] = hi16(kv[i]); }
#pragma unroll
                for (int i = 0; i < 8; ++i) kf[i] *= __expf(laf[63 * 128 + 8 * c8 + i] - laf[jj * 128 + 8 * c8 + i]);
                v4u p; p.x = pk2(kf[0], kf[1]); p.y = pk2(kf[2], kf[3]); p.z = pk2(kf[4], kf[5]); p.w = pk2(kf[6], kf[7]);
                *(LAS v4u*)(kw + jj * LKW + 8 * c8) = p; }
        }
        { const int vcol = hh < 4 ? EC_MV + hh * 256 : EC_GV + (hh - 4) * 256;
          for (int it = tid; it < 2048; it += NTHR) { const int jj = it >> 5, c8 = it & 31; *(LAS v4u*)(vv + jj * LVV + 8 * c8) = *(const GAS v4u*)(PROJ + (size_t)(t0 + jj) * NE + vcol + 8 * c8); } }
        __syncthreads();
        { const int db = wave & 3;
          for (int e4 = 0; e4 < 4; ++e4) { const int eb = (wave >> 2) * 4 + e4; f32x16 acc = zero16();
#pragma unroll
              for (int ks = 0; ks < 4; ++ks) { const bf16x8 A = frag_tr(kw, LKW, 16 * ks, 32 * db, lane), B = frag_tr(vv, LVV, 16 * ks, 32 * eb, lane); acc = MFMA32(A, B, acc); }
              GAS bf16* dst = ST + (size_t)(n * 8 + hh) * 32768 + 4 * h;
#pragma unroll
              for (int g4 = 0; g4 < 4; ++g4) { v2u w2; w2.x = pk2(acc[4 * g4], acc[4 * g4 + 1]); w2.y = pk2(acc[4 * g4 + 2], acc[4 * g4 + 3]);
                  *(GAS v2u*)(dst + (((eb * 8 + 2 * db + (g4 >> 1)) * 64 + 32 * (g4 & 1) + r) * 8)) = w2; } } }
        if (hh < 4 && tid < 128) { float s = 0.f; for (int jj = 0; jj < 64; ++jj) s += bf2f(kw[jj * LKW + tid]); NST[(n * 4 + hh) * 128 + tid] = s; }
    }
}
__device__ __forceinline__ void phase_scan(ArgsP ap, LW lds_) {
    const CONSTAS Args& a = *ap; const Ctx c = make_ctx(lds_); GAS unsigned char* ws = opaque_ws(a.ws); GAS unsigned* ST = (GAS unsigned*)(ws + WS_STATES);
    const GAS float* MST = (const GAS float*)(ws + WS_MST); GAS float* MPREV = (GAS float*)(ws + WS_MPREV); GAS float* NST = (GAS float*)(ws + WS_NST); const GAS float* LAL = (const GAS float*)(ws + WS_LAL);
    constexpr int NSTR = 8 * 256 * 64;
    for (int p0 = blockIdx.x * NTHR + c.tid; p0 < 8 * 256 * 64; p0 += gridDim.x * NTHR) {
        const int W_ = p0 >> 6, p = ((4 * ((W_ >> 2) & 1) + (W_ & 3)) << 14) + ((W_ >> 3) << 6) + (p0 & 63);
        const int hh = p >> 14, w = p & 16383, e = ((w >> 11) << 5) | ((w >> 2) & 31), dp = 8 * ((w >> 8) & 7) + 4 * ((w >> 7) & 1) + (w & 3);
        GAS unsigned* st = ST + (size_t)hh * 16384 + w;
        float c0 = 0.f, c1 = 0.f;
        if (hh < 4) {
            float m = 0.f, n0 = 0.f, n1 = 0.f; const bool nrm = e == 0;
            unsigned lda[16], ldb[16]; f2v gma[16], nla[16], gmb[16], nlb[16];
#define SC_LOADM(NB, LD, GM, NL) do { _Pragma("unroll") for (int k = 0; k < 16; ++k) LD[k] = st[(size_t)((NB) + k) * NSTR]; \
                _Pragma("unroll") for (int k = 0; k < 16; ++k) GM[k] = *(const GAS f2v*)(MST + (((NB) + k) * 4 + hh) * 2); \
                _Pragma("unroll") for (int k = 0; k < 16; ++k) NL[k] = *(const GAS f2v*)(NST + (((NB) + k) * 4 + hh) * 128 + 2 * dp);        \
                __builtin_amdgcn_sched_barrier(0); } while (0)
#define SC_RUNM(NB, LD, GM, NL) do { _Pragma("unroll") for (int k = 0; k < 16; ++k) { const int n = (NB) + k; const float g = GM[k].x, ml = GM[k].y; \
                    const float mn = fmaxf(g + m, ml), so = __expf(g + m - mn), sl = __expf(ml - mn); \
                    st[(size_t)n * NSTR] = pk2(c0, c1); c0 = so * c0 + sl * lo16(LD[k]); c1 = so * c1 + sl * hi16(LD[k]); \
                    if (nrm) { *(GAS f2v*)(NST + (n * 4 + hh) * 128 + 2 * dp) = (f2v){n0, n1}; n0 = so * n0 + sl * NL[k].x; n1 = so * n1 + sl * NL[k].y; \
                        if (dp == 0) MPREV[n * 4 + hh] = m; } \
                    m = mn; } __builtin_amdgcn_sched_barrier(0); } while (0)
            SC_LOADM(0, lda, gma, nla);
            for (int nb = 0; nb < 256; nb += 32) {
                SC_LOADM(nb + 16, ldb, gmb, nlb); SC_RUNM(nb, lda, gma, nla);
                if (nb + 32 < 256) SC_LOADM(nb + 32, lda, gma, nla);
                SC_RUNM(nb + 16, ldb, gmb, nlb); }
#undef SC_RUNM
#undef SC_LOADM
        } else {
            const int g = hh - 4;
            unsigned lda[16], ldb[16]; f2v dla[16], dlb[16];
#define SC_LOADG(NB, LD, DL) do { _Pragma("unroll") for (int k = 0; k < 16; ++k) LD[k] = st[(size_t)((NB) + k) * NSTR]; \
                _Pragma("unroll") for (int k = 0; k < 16; ++k) DL[k] = *(const GAS f2v*)(LAL + (((NB) + k) * 4 + g) * 128 + 2 * dp); \
                __builtin_amdgcn_sched_barrier(0); } while (0)
#define SC_RUNG(NB, LD, DL) do { _Pragma("unroll") for (int k = 0; k < 16; ++k) { const int n = (NB) + k; \
                    st[(size_t)n * NSTR] = pk2(c0, c1); c0 = __expf(DL[k].x) * c0 + lo16(LD[k]); c1 = __expf(DL[k].y) * c1 + hi16(LD[k]); } __builtin_amdgcn_sched_barrier(0); } while (0)
            SC_LOADG(0, lda, dla);
            for (int nb = 0; nb < 256; nb += 32) {
                SC_LOADG(nb + 16, ldb, dlb); SC_RUNG(nb, lda, dla);
                if (nb + 32 < 256) SC_LOADG(nb + 32, lda, dla);
                SC_RUNG(nb + 16, ldb, dlb); }
#undef SC_RUNG
#undef SC_LOADG
        }
    }
}
__device__ __forceinline__ void phase_chunk_c(ArgsP ap, LW lds_, int jl) {
    const CONSTAS Args& a = *ap; const Ctx c = make_ctx(lds_); GAS unsigned char* ws = opaque_ws(a.ws); const GAS bf16* PROJ = (const GAS bf16*)(ws + WS_PROJ); const GAS float* SMALL = (const GAS float*)(ws + WS_SMALL);
    const GAS bf16* ST = (const GAS bf16*)(ws + WS_STATES); const GAS bf16* QKC = (const GAS bf16*)(ws + WS_QKC); const GAS float* LA = (const GAS float*)(ws + WS_LA);
    const GAS float* MPREV = (const GAS float*)(ws + WS_MPREV); const GAS float* NST = (const GAS float*)(ws + WS_NST); GAS bf16* MIXO = (GAS bf16*)(ws + WS_MIXO);
    LAS bf16* qa = (LAS bf16*)(c.lds); LAS bf16* kb = (LAS bf16*)(c.lds + 17408); LAS bf16* vv = (LAS bf16*)(c.lds + 34816); LAS bf16* P = (LAS bf16*)(c.lds + 69632);
    LAS float* bvec = (LAS float*)(c.lds + 78848); LAS float* igv = bvec + 64; LAS float* mqv = bvec + 128; LAS float* sint = bvec + 192; LAS float* dn = bvec + 256; LAS float* rstd = bvec + 320;
    LAS float* rsq = bvec + 384; LAS float* nprev = bvec + 384 + 512; LAS bf16* qsm = (LAS bf16*)(c.lds + 82944); LAS bf16* ost = (LAS bf16*)(c.lds + 100352);
    const int tid = c.tid, lane = c.lane, wave = c.wave, r = lane & 31, h = lane >> 5;
    for (int u = blockIdx.x; u < 2048; u += gridDim.x) {
        const int n = u >> 3, hh = (u + (u >> 8)) & 7, t0 = n * 64, g = hh - 4;
        LAS bf16* qs = hh < 4 ? qsm : qa;
        __syncthreads();
        if (hh < 4 && wave == 0) {
            const GAS float* sm = SMALL + (size_t)(t0 + lane) * 128;
            const float ig = sm[hh] + ((const GAS float*)a.ab_igate_b)[jl * 4 + hh]; const float lf = logsigmoidf_(sm[4 + hh] + ((const GAS float*)a.ab_fgate_b)[jl * 4 + hh]);
            float b = lf;
#pragma unroll
            for (int o = 1; o < 64; o <<= 1) { const float y = __shfl_up(b, o); if (lane >= o) b += y; }
            float mx = ig - b;
#pragma unroll
            for (int o = 1; o < 64; o <<= 1) { const float y = __shfl_up(mx, o); if (lane >= o) mx = fmaxf(mx, y); }
            const float mp = MPREV[n * 4 + hh]; const float mq = b + fmaxf(mp, mx);
            bvec[lane] = b; igv[lane] = ig; mqv[lane] = mq; sint[lane] = __expf(b + mp - mq);
        }
        __syncthreads();
        if (hh < 4) {
            for (int it = tid; it < 2048; it += NTHR) { const int which = it >> 10, jj = (it >> 4) & 63, c8 = it & 15;
                const v4u x = *(const GAS v4u*)(QKC + (size_t)(t0 + jj) * 1024 + which * 512 + hh * 128 + 8 * c8);
                *(LAS v4u*)((which ? kb : qa) + jj * LQ + 8 * c8) = x;
                if (which == 0) { const float si = sint[jj]; v4u y;
#pragma unroll
                    for (int i = 0; i < 4; ++i) y[i] = pk2(lo16(x[i]) * si, hi16(x[i]) * si);
                    *(LAS v4u*)(qsm + jj * LQ + 8 * c8) = y; } }
            if (tid < 128) nprev[tid] = NST[(n * 4 + hh) * 128 + tid];
        } else {
            for (int it = tid; it < 1024; it += NTHR) { const int jj = it >> 4, c8 = it & 15; const size_t t = t0 + jj;
                const v4u qv = *(const GAS v4u*)(PROJ + t * NE + EC_GQ + g * 128 + 8 * c8), kv = *(const GAS v4u*)(PROJ + t * NE + EC_GK + g * 128 + 8 * c8);
                const f32x4 l0 = *(const GAS f32x4*)(LA + t * 512 + g * 128 + 8 * c8), l1 = *(const GAS f32x4*)(LA + t * 512 + g * 128 + 8 * c8 + 4);
                float qf[8], kf[8], el[8];
#pragma unroll
                for (int i = 0; i < 4; ++i) { qf[2 * i] = lo16(qv[i]); qf[2 * i + 1] = hi16(qv[i]); kf[2 * i] = lo16(kv[i]); kf[2 * i + 1] = hi16(kv[i]); el[i] = l0[i]; el[4 + i] = l1[i]; }
#pragma unroll
                for (int i = 0; i < 8; ++i) { qf[i] *= RSQ_DK * __expf(el[i]); kf[i] *= __expf(-el[i]); }
                v4u o; o.x = pk2(qf[0], qf[1]); o.y = pk2(qf[2], qf[3]); o.z = pk2(qf[4], qf[5]); o.w = pk2(qf[6], qf[7]); *(LAS v4u*)(qa + jj * LQ + 8 * c8) = o;
                v4u p; p.x = pk2(kf[0], kf[1]); p.y = pk2(kf[2], kf[3]); p.z = pk2(kf[4], kf[5]); p.w = pk2(kf[6], kf[7]); *(LAS v4u*)(kb + jj * LQ + 8 * c8) = p; }
        }
        { const int vcol = hh < 4 ? EC_MV + hh * 256 : EC_GV + g * 256;
          for (int it = tid; it < 2048; it += NTHR) { const int jj = it >> 5, c8 = it & 31; *(LAS v4u*)(vv + jj * LVV + 8 * c8) = *(const GAS v4u*)(PROJ + (size_t)(t0 + jj) * NE + vcol + 8 * c8); } }
        __syncthreads();
        if (wave < 4) { const int ib = wave >> 1, jb = wave & 1; f32x16 acc = zero16();
            if (jb <= ib) {
#pragma unroll
                for (int ks = 0; ks < 8; ++ks) { const bf16x8 A = frag_v(qa + (32 * ib + r) * LQ + 16 * ks + 8 * h), B = frag_v(kb + (32 * jb + r) * LQ + 16 * ks + 8 * h); acc = MFMA32(A, B, acc); } }
            const int jc = 32 * jb + r;
#pragma unroll
            for (int reg = 0; reg < 16; ++reg) { const int i = 32 * ib + drow(reg, h); float wv = 0.f;
                if (jc <= i) wv = hh < 4 ? acc[reg] * __expf(bvec[i] - bvec[jc] + igv[jc] - mqv[i]) : acc[reg];
                P[i * LP + jc] = (bf16)f2bf(wv); } }
        __syncthreads();
        if (hh < 4 && tid < 64) { const int i = tid; float s = 0.f; for (int jj = 0; jj < 64; ++jj) s += bf2f(P[i * LP + jj]);
            float qn = 0.f; for (int d = 0; d < 128; ++d) qn += bf2f(qa[i * LQ + d]) * nprev[d];
            dn[i] = fmaxf(fabsf(s + sint[i] * qn), __expf(-mqv[i])); }
        const int eb = wave;
#pragma unroll 1
        for (int ib = 0; ib < 2; ++ib) { f32x16 acc = zero16();
#pragma unroll
            for (int ks = 0; ks < 4; ++ks) { const bf16x8 B = frag_tr(vv, LVV, 16 * ks, 32 * eb, lane), A = frag_v(P + (32 * ib + r) * LP + 16 * ks + 8 * h); acc = MFMA32(A, B, acc); }
#pragma unroll
            for (int ks = 0; ks < 8; ++ks) { const bf16x8 B = *(const GAS bf16x8*)(ST + (size_t)(n * 8 + hh) * 32768 + ((eb * 8 + ks) * 64 + lane) * 8), A = frag_v(qs + (32 * ib + r) * LQ + 16 * ks + 8 * h); acc = MFMA32(A, B, acc); }
#pragma unroll
            for (int reg = 0; reg < 16; ++reg) { const int i = 32 * ib + drow(reg, h); const float o = acc[reg]; ost[i * LV + 32 * eb + r] = (bf16)f2bf(o); float sq = o * o;
#pragma unroll
                for (int of = 1; of < 32; of <<= 1) sq += __shfl_xor(sq, of);
                if (r == 0) rsq[i * 8 + wave] = sq; } }
        __syncthreads();
        if (tid < 64) { float s = 0.f;
#pragma unroll
            for (int w = 0; w < 8; ++w) s += rsq[tid * 8 + w];
            const float inv = hh < 4 ? 1.0f / dn[tid] : 1.0f;
            rstd[tid] = inv / sqrtf(s * inv * inv * (1.0f / 256.0f) + HN_EPS); }
        __syncthreads();
        { const GAS float* gainp = hh < 4 ? ((const GAS float*)a.ab_mnorm) + jl * 1024 + hh * 256 : ((const GAS float*)a.ab_gnorm) + jl * 1024 + g * 256;
          const int gcol = hh < 4 ? EC_MO + hh * 256 : EC_GR + g * 256, ocol = hh < 4 ? hh * 256 : 1024 + g * 256;
          for (int it = tid; it < 2048; it += NTHR) { const int i = it >> 5, c8 = it & 31; const size_t t = t0 + i;
              const v4u nv = *(const LAS v4u*)(ost + i * LV + 8 * c8), gv = *(const GAS v4u*)(PROJ + t * NE + gcol + 8 * c8);
              const f32x4 g0 = *(const GAS f32x4*)(gainp + 8 * c8), g1 = *(const GAS f32x4*)(gainp + 8 * c8 + 4); const float rs = rstd[i]; float o[8];
#pragma unroll
              for (int k = 0; k < 4; ++k) { const float x0 = lo16(gv[k]), x1 = hi16(gv[k]); const float t0g = hh < 4 ? sigmoidf_(x0) : x0 * sigmoidf_(x0), t1g = hh < 4 ? sigmoidf_(x1) : x1 * sigmoidf_(x1);
                  o[2 * k] = lo16(nv[k]) * rs * t0g; o[2 * k + 1] = hi16(nv[k]) * rs * t1g; }
              v4u w; w.x = pk2(o[0] * g0[0], o[1] * g0[1]); w.y = pk2(o[2] * g0[2], o[3] * g0[3]); w.z = pk2(o[4] * g1[0], o[5] * g1[1]); w.w = pk2(o[6] * g1[2], o[7] * g1[3]);
              *(GAS v4u*)(MIXO + t * D + ocol + 8 * c8) = w; } }
    }
}

constexpr size_t WS_K8 = WS_STATES, WS_V8 = WS_STATES + 8 * MiB;
__device__ __forceinline__ void rope8(float (&x)[8], const v4u raw, const f2v (&cs)[8], int pairbit, int dsel, int nrot) {
    v4u pr;
#pragma unroll
    for (int i = 0; i < 4; ++i) pr[i] = (unsigned)__shfl_xor((int)raw[i], pairbit);
    if (dsel < 2 * nrot) { const float sg = dsel < nrot ? -1.0f : 1.0f;
#pragma unroll
        for (int i = 0; i < 8; ++i) { const float y = (i & 1) ? hi16(pr[i >> 1]) : lo16(pr[i >> 1]); x[i] = x[i] * cs[i].x + sg * y * cs[i].y; } }
}
__device__ __forceinline__ void phase_rope(ArgsP ap, LW lds_) {
    const CONSTAS Args& a = *ap; const Ctx c = make_ctx(lds_); GAS unsigned char* ws = opaque_ws(a.ws); GAS bf16* PROJ = (GAS bf16*)(ws + WS_PROJ); const GAS float* SMALL = (const GAS float*)(ws + WS_SMALL); const GAS f2v* ROPE = (const GAS f2v*)(ws + WS_ROPE); GAS bf16* KI = (GAS bf16*)(ws + WS_KI);
    GAS unsigned char* K8 = ws + WS_K8; GAS unsigned char* V8 = ws + WS_V8;
    const int gw = blockIdx.x * NWAVES + c.wave, NGW = gridDim.x * NWAVES, lane = c.lane;
    const int dA = lane & 15, dB = lane & 7, d = lane; const bool actA = dA < 4, actB = dB < 2;
    v4u rawA[6], rawB[2]; f2v csA[8], csB[8]; float xk = 0.f, xp = 0.f; f2v csK = {1.f, 0.f};
    v4u nrawA[6], nrawB[2]; f2v ncsA[8], ncsB[8]; float nxk = 0.f, nxp = 0.f; f2v ncsK = {1.f, 0.f};
#define ROPE_LOADS(TT, RA, RB, CA, CB, XK, XP, CK) do { const GAS f2v* rp_ = ROPE + (size_t)(TT) * 16; const GAS bf16* pr_ = PROJ + (size_t)(TT) * NO; \
        _Pragma("unroll") for (int j = 0; j < 6; ++j) { const int col = (j < 4 ? OC_Q + 512 * j : (j == 4 ? OC_K : OC_V)) + 8 * lane; RA[j] = (v4u){0u, 0u, 0u, 0u}; if (j >= 4 || actA) RA[j] = *(const GAS v4u*)(pr_ + col); } \
        _Pragma("unroll") for (int j = 0; j < 2; ++j) { RB[j] = (v4u){0u, 0u, 0u, 0u}; if (actB) RB[j] = *(const GAS v4u*)(pr_ + OC_QI + 512 * j + 8 * lane); } \
        { const int f0 = 8 * (dA & 1);        \
          _Pragma("unroll") for (int i = 0; i < 8; ++i) { CA[i] = (f2v){1.f, 0.f}; if (actA) CA[i] = rp_[f0 + i]; CB[i] = (f2v){1.f, 0.f}; if (actB) CB[i] = rp_[2 * i]; } } \
        { const GAS float* sm_ = SMALL + (size_t)(TT) * 128; XK = sm_[d]; XP = 0.f; CK = (f2v){1.f, 0.f}; if (d < 16) { XP = sm_[d < 8 ? d + 8 : d - 8]; CK = rp_[2 * (d & 7)]; } } \
        __builtin_amdgcn_sched_barrier(0); } while (0)
    if (gw < T) ROPE_LOADS(gw, rawA, rawB, csA, csB, xk, xp, csK);
    for (int t = gw; t < T; t += NGW) {
        GAS bf16* pr = PROJ + (size_t)t * NO;
        if (t + NGW < T) ROPE_LOADS(t + NGW, nrawA, nrawB, ncsA, ncsB, nxk, nxp, ncsK);
        __builtin_amdgcn_sched_barrier(0);
        v4u outA[4], outB[2]; v2u out8[2];
#pragma unroll
        for (int j = 0; j < 6; ++j) { float x[8];
#pragma unroll
            for (int i = 0; i < 4; ++i) { x[2 * i] = lo16(rawA[j][i]); x[2 * i + 1] = hi16(rawA[j][i]); }
            if (j < 5) rope8(x, rawA[j], csA, 2, dA, 2);
            if (j < 4) { outA[j].x = pk2(x[0], x[1]); outA[j].y = pk2(x[2], x[3]); outA[j].z = pk2(x[4], x[5]); outA[j].w = pk2(x[6], x[7]); }
            else { int w0 = __builtin_amdgcn_cvt_pk_fp8_f32(x[0] * 16.f, x[1] * 16.f, 0, false); w0 = __builtin_amdgcn_cvt_pk_fp8_f32(x[2] * 16.f, x[3] * 16.f, w0, true);
                   int w1 = __builtin_amdgcn_cvt_pk_fp8_f32(x[4] * 16.f, x[5] * 16.f, 0, false); w1 = __builtin_amdgcn_cvt_pk_fp8_f32(x[6] * 16.f, x[7] * 16.f, w1, true);
                   out8[j - 4] = (v2u){(unsigned)w0, (unsigned)w1}; } }
#pragma unroll
        for (int j = 0; j < 2; ++j) { float x[8];
#pragma unroll
            for (int i = 0; i < 4; ++i) { x[2 * i] = lo16(rawB[j][i]); x[2 * i + 1] = hi16(rawB[j][i]); }
            rope8(x, rawB[j], csB, 1, dB, 1);
            outB[j].x = pk2(x[0], x[1]); outB[j].y = pk2(x[2], x[3]); outB[j].z = pk2(x[4], x[5]); outB[j].w = pk2(x[6], x[7]); }
        float ok = xk;
        if (d < 8) ok = xk * csK.x - xp * csK.y; else if (d < 16) ok = xk * csK.x + xp * csK.y;
#pragma unroll
        for (int j = 0; j < 4; ++j) if (actA) *(GAS v4u*)(pr + OC_Q + 512 * j + 8 * lane) = outA[j];
        *(GAS v2u*)(K8 + (size_t)t * 512 + 8 * lane) = out8[0]; *(GAS v2u*)(V8 + (size_t)t * 512 + 8 * lane) = out8[1];
#pragma unroll
        for (int j = 0; j < 2; ++j) if (actB) *(GAS v4u*)(pr + OC_QI + 512 * j + 8 * lane) = outB[j];
        KI[((size_t)((t >> 5) * 4 + (d >> 4)) * 64 + ((d >> 3) & 1) * 32 + (t & 31)) * 8 + (d & 7)] = (bf16)f2bf(ok);
#pragma unroll
        for (int j = 0; j < 6; ++j) rawA[j] = nrawA[j];
#pragma unroll
        for (int j = 0; j < 2; ++j) rawB[j] = nrawB[j];
#pragma unroll
        for (int i = 0; i < 8; ++i) { csA[i] = ncsA[i]; csB[i] = ncsB[i]; }
        xk = nxk; xp = nxp; csK = ncsK;
    }
#undef ROPE_LOADS
}
__device__ __forceinline__ unsigned short score_code(float s) { const _Float16 hv = (_Float16)s; const unsigned short hb = __builtin_bit_cast(unsigned short, hv); return (hb & 0x8000u) ? (unsigned short)~hb : (unsigned short)(hb | 0x8000u); }
__device__ __forceinline__ int wave_incl_scan_dpp(int v) {
    v += __builtin_amdgcn_update_dpp(0, v, 0x111, 0xf, 0xf, true);
    v += __builtin_amdgcn_update_dpp(0, v, 0x112, 0xf, 0xf, true);
    v += __builtin_amdgcn_update_dpp(0, v, 0x114, 0xf, 0xf, true);
    v += __builtin_amdgcn_update_dpp(0, v, 0x118, 0xf, 0xf, true);
    v += __builtin_amdgcn_update_dpp(0, v, 0x142, 0xa, 0xf, false);
    v += __builtin_amdgcn_update_dpp(0, v, 0x143, 0xc, 0xf, false);
    return v;
}
__device__ __forceinline__ void find_bin(const LAS unsigned* hA, const LAS unsigned* hB, int target, int lane, int& bin, int& above) {
    int h0 = (int)hA[4 * lane], h1 = (int)hA[4 * lane + 1], h2 = (int)hA[4 * lane + 2], h3 = (int)hA[4 * lane + 3];
    if (hB) { h0 += (int)hB[4 * lane]; h1 += (int)hB[4 * lane + 1]; h2 += (int)hB[4 * lane + 2]; h3 += (int)hB[4 * lane + 3]; }
    const int s = h0 + h1 + h2 + h3; const int incl = wave_incl_scan_dpp(s);
    const int suf = __builtin_amdgcn_readlane(incl, 63) - incl; const bool found = (suf < target) && (suf + s >= target);
    int b = 0, ab = 0; { int run = suf;
        if (run + h3 >= target) { b = 4 * lane + 3; ab = run; } else { run += h3;
        if (run + h2 >= target) { b = 4 * lane + 2; ab = run; } else { run += h2;
        if (run + h1 >= target) { b = 4 * lane + 1; ab = run; } else { run += h1; b = 4 * lane; ab = run; } } } }
    const unsigned long long m = __ballot(found); const int src = m ? (int)__builtin_ctzll(m) : 0;
    bin = __builtin_amdgcn_readlane(b, src); above = __builtin_amdgcn_readlane(ab, src);
}
__device__ __forceinline__ int wave_incl_scan(int v, int lane) {
#pragma unroll
    for (int o = 1; o < 64; o <<= 1) { const int y = __shfl_up(v, o); if (lane >= o) v += y; }
    return v;
}
__device__ __forceinline__ int mbcnt64(unsigned long long m, int add) { return (int)__builtin_amdgcn_mbcnt_hi((unsigned)(m >> 32), __builtin_amdgcn_mbcnt_lo((unsigned)m, (unsigned)add)); }
__device__ __forceinline__ void phase_index(ArgsP ap, LW lds_) {
    const CONSTAS Args& a = *ap; const Ctx c = make_ctx(lds_); GAS unsigned char* ws = opaque_ws(a.ws); const GAS bf16* PROJ = (const GAS bf16*)(ws + WS_PROJ); const GAS float* SMALL = (const GAS float*)(ws + WS_SMALL); const GAS bf16* KI = (const GAS bf16*)(ws + WS_KI); GAS unsigned short* SEL = (GAS unsigned short*)(ws + WS_SEL);
    LAS unsigned short* codes = (LAS unsigned short*)c.lds; LAS unsigned* hist1 = (LAS unsigned*)(c.lds + 131072); LAS unsigned* hist2 = (LAS unsigned*)(c.lds + 135168);
    const int tid = c.tid, lane = c.lane, wave = c.wave, r = lane & 31, h = lane >> 5;
    for (int rnd = 0; rnd * (int)gridDim.x < T / 4; ++rnd) {
        const int task = rnd * (int)gridDim.x + ((rnd & 1) ? (int)gridDim.x - 1 - (int)blockIdx.x : (int)blockIdx.x); if (task >= T / 4) continue;
        const int t0 = 4 * (T / 4 - 1 - task), nkt = (t0 + 4 + 31) >> 5;
        __syncthreads();
        for (int i = tid; i < 3073; i += NTHR) hist1[i] = 0u;
        bf16x8 A[2][4]; float wv[2][2][8];
#pragma unroll
        for (int rb = 0; rb < 2; ++rb) {
#pragma unroll
            for (int ks = 0; ks < 4; ++ks) A[rb][ks] = *(const GAS bf16x8*)(PROJ + (size_t)(t0 + 2 * rb + (r >> 4)) * NO + OC_QI + (r & 15) * 64 + 16 * ks + 8 * h);
#pragma unroll
            for (int qq = 0; qq < 2; ++qq) { const GAS float* wp = SMALL + (size_t)(t0 + 2 * rb + qq) * 128 + 64 + 4 * h; const f32x4 w0 = *(const GAS f32x4*)wp, w1 = *(const GAS f32x4*)(wp + 8);
#pragma unroll
                for (int k = 0; k < 4; ++k) { wv[rb][qq][k] = w0[k] * (1.0f / 64.0f); wv[rb][qq][4 + k] = w1[k] * (1.0f / 64.0f); } } }
        __syncthreads();
        const int nit = nkt > wave ? (nkt - wave + 7) >> 3 : 0;
        if (nit > 0) {
            bf16x8 Bqu[3][4];
#pragma unroll
            for (int sl = 0; sl < 3; ++sl) { int kt = wave + 8 * sl; kt = kt < nkt ? kt : nkt - 1;
#pragma unroll
                for (int ks = 0; ks < 4; ++ks) Bqu[sl][ks] = *(const GAS bf16x8*)(KI + ((size_t)(kt * 4 + ks) * 64 + lane) * 8); }
            for (int it0 = 0; it0 < nit; it0 += 3) {
#pragma unroll
                for (int sl = 0; sl < 3; ++sl) { const int it = it0 + sl, kt = wave + 8 * it;
                    if (it < nit) { const int key = 32 * kt + r; f32x16 acc0 = zero16(), acc1 = zero16();
#pragma unroll
                        for (int ks = 0; ks < 4; ++ks) { acc0 = MFMA32(A[0][ks], Bqu[sl][ks], acc0); acc1 = MFMA32(A[1][ks], Bqu[sl][ks], acc1); }
#pragma unroll
                        for (int rb = 0; rb < 2; ++rb) { float s0 = 0.f, s1 = 0.f;
#pragma unroll
                            for (int k8 = 0; k8 < 8; ++k8) { const float x0 = rb ? acc1[k8] : acc0[k8], x1 = rb ? acc1[8 + k8] : acc0[8 + k8];
                                s0 = fmaf(wv[rb][0][k8], x0, s0); s0 = fmaf(wv[rb][0][k8], fabsf(x0), s0); s1 = fmaf(wv[rb][1][k8], x1, s1); s1 = fmaf(wv[rb][1][k8], fabsf(x1), s1); }
                            const auto sw = __builtin_amdgcn_permlane32_swap(__float_as_uint(s0), __float_as_uint(s1), false, false);
                            const float sc = __uint_as_float(sw[0]) + __uint_as_float(sw[1]);
                            const int qq = 2 * rb + h; const bool valid = key <= t0 + qq; const unsigned cdv = valid ? (unsigned)score_code(sc) : 0u;
                            codes[qq * 16384 + key] = (unsigned short)cdv;
                            __hip_atomic_fetch_add(hist1 + (valid ? qq * 256 + (int)(cdv >> 8) : 3072), 1u, __ATOMIC_RELAXED, __HIP_MEMORY_SCOPE_WORKGROUP); } }
                    { int kn = kt + 24; kn = kn < nkt ? kn : nkt - 1;
#pragma unroll
                      for (int ks = 0; ks < 4; ++ks) Bqu[sl][ks] = *(const GAS bf16x8*)(KI + ((size_t)(kn * 4 + ks) * 64 + lane) * 8); } } } }
        __syncthreads();
        const int row = wave >> 1, half = wave & 1, t = t0 + row, nv = t + 1; const bool small = nv <= 256;
        const LAS unsigned short* cd = codes + row * 16384; GAS unsigned short* out = SEL + (size_t)t * 256;
        const int nvh = (((nv + 1) >> 1) + 511) & ~511; const int beg = half ? nvh : 0, end = half ? nv : (nvh < nv ? nvh : nv);
        int b1 = 0, ab1 = 0;
        if (!small) { find_bin(hist1 + row * 256, nullptr, 256, lane, b1, ab1);
            for (int base = beg + 8 * lane; base < end; base += 512) { const v4u c8 = *(const LAS v4u*)(cd + base);
                unsigned mm = 0u;
#pragma unroll
                for (int j = 0; j < 8; ++j) { const unsigned cv = (j & 1) ? (c8[j >> 1] >> 16) : (c8[j >> 1] & 0xffffu); mm |= (base + j < end && (int)(cv >> 8) == b1) ? (1u << j) : 0u; }
                while (mm) { const int j = __builtin_ctz(mm); mm &= mm - 1u;
                    const unsigned w_ = j < 4 ? (j < 2 ? c8[0] : c8[1]) : (j < 6 ? c8[2] : c8[3]); const unsigned cv = (j & 1) ? (w_ >> 16) : (w_ & 0xffffu);
                    __hip_atomic_fetch_add(hist2 + (row * 2 + half) * 256 + (cv & 255u), 1u, __ATOMIC_RELAXED, __HIP_MEMORY_SCOPE_WORKGROUP); } } }
        __syncthreads();
        if (small) { if (half == 0) for (int i = lane; i < nv; i += 64) out[i] = (unsigned short)i; }
        else {
            int b2, ab2; find_bin(hist2 + row * 512, hist2 + row * 512 + 256, 256 - ab1, lane, b2, ab2);
            const int eq0 = (int)hist2[row * 512 + b2], need_eq = 256 - ab1 - ab2; const int my_need = half ? (need_eq - eq0 > 0 ? need_eq - eq0 : 0) : (need_eq < eq0 ? need_eq : eq0);
            const unsigned thr = ((unsigned)b1 << 8) | (unsigned)b2; int run = 0, run_eq = 0;
            for (int base0 = beg; base0 < end; base0 += 512) { const int base = base0 + 8 * lane; v4u c8 = (v4u){0u, 0u, 0u, 0u}; if (base < end) c8 = *(const LAS v4u*)(cd + base);
                unsigned gtm = 0u, eqm = 0u;
#pragma unroll
                for (int j = 0; j < 8; ++j) { const unsigned cv = (j & 1) ? (c8[j >> 1] >> 16) : (c8[j >> 1] & 0xffffu); const bool ok = base + j < end;
                    gtm |= (ok && cv > thr) ? (1u << j) : 0u; eqm |= (ok && cv == thr) ? (1u << j) : 0u; }
                unsigned tm = gtm;
                if (__ballot(eqm != 0u)) {
                    int er = run_eq, tot = 0;
#pragma unroll
                    for (int j = 0; j < 8; ++j) { const unsigned long long bj = __ballot((eqm >> j) & 1u); er = mbcnt64(bj, er); tot += __popcll(bj); }
#pragma unroll
                    for (int j = 0; j < 8; ++j) if ((eqm >> j) & 1u) { if (er < my_need) tm |= (1u << j); ++er; }
                    run_eq += tot; }
                const int cnt = __popc(tm), incl = wave_incl_scan_dpp(cnt), tot = __builtin_amdgcn_readlane(incl, 63);
                int pos = run + incl - cnt;
                while (tm) { const int j = __builtin_ctz(tm); tm &= tm - 1u; const int pp = half ? 255 - pos : pos; if (pp >= 0 && pp < 256) out[pp] = (unsigned short)(base + j); ++pos; }
                run += tot; }
        }
    }
}
#define MFMA16(a, b, c) __builtin_amdgcn_mfma_f32_16x16x32_bf16((a), (b), (c), 0, 0, 0)
constexpr int CW_ACNT = 12288;
constexpr int LVA = 144;

__device__ __forceinline__ void attn_task(const GAS bf16* PROJ, const GAS unsigned char* K8, const GAS unsigned char* V8, const GAS unsigned short* SEL, GAS bf16* MIXO, LAS bf16* kt, LAS bf16* vt, LAS unsigned short* ksm, int t, int g, int lane) {
    const int c16 = lane & 15, q4 = lane >> 4, nk = t + 1 < 256 ? t + 1 : 256, nst = (nk + 31) >> 5;
    const GAS char* pb = (const GAS char*)PROJ;
#pragma unroll
    for (int i = 0; i < 4; ++i) { const int k = lane + 64 * i; ksm[k] = k < nk ? SEL[(size_t)t * 256 + k] : (unsigned short)0; }
    bf16x8 Bq[4];
#pragma unroll
    for (int ks = 0; ks < 4; ++ks) { bf16x8 z = {0, 0, 0, 0, 0, 0, 0, 0}; if (c16 < 4) z = *(const GAS bf16x8*)(pb + (unsigned)((t * NO + OC_Q + (4 * g + c16) * 128 + 32 * ks + 8 * q4) * 2)); Bq[ks] = z; }
    v4u rk[4], rv[4];
    const int r8 = lane >> 3, c8 = lane & 7; const unsigned coff = (unsigned)(g * 128 + 16 * c8);
#pragma unroll
    for (int i = 0; i < 4; ++i) { const unsigned ro = (unsigned)(ksm[r8 + 8 * i] * 512) + coff; rk[i] = *(const GAS v4u*)(K8 + ro); rv[i] = *(const GAS v4u*)(V8 + ro); }
    float m = -1e30f, ssum = 0.f; f32x4 o[8];
#pragma unroll
    for (int dt = 0; dt < 8; ++dt) o[dt] = (f32x4){0.f, 0.f, 0.f, 0.f};
    const LAS bf16* trp = vt + (4 * q4 + (c16 >> 2)) * LVA + 4 * (c16 & 3);
#pragma unroll 1
    for (int st = 0; st < nst; ++st) {
#pragma unroll
        for (int i = 0; i < 4; ++i) { v4u a0, a1, b0, b1;
#pragma unroll
            for (int w = 0; w < 2; ++w) {
                a0[2 * w] = __builtin_bit_cast(unsigned, __builtin_amdgcn_cvt_scalef32_pk_bf16_fp8(rk[i][w], 1.0f, false)); a0[2 * w + 1] = __builtin_bit_cast(unsigned, __builtin_amdgcn_cvt_scalef32_pk_bf16_fp8(rk[i][w], 1.0f, true));
                a1[2 * w] = __builtin_bit_cast(unsigned, __builtin_amdgcn_cvt_scalef32_pk_bf16_fp8(rk[i][2 + w], 1.0f, false)); a1[2 * w + 1] = __builtin_bit_cast(unsigned, __builtin_amdgcn_cvt_scalef32_pk_bf16_fp8(rk[i][2 + w], 1.0f, true));
                b0[2 * w] = __builtin_bit_cast(unsigned, __builtin_amdgcn_cvt_scalef32_pk_bf16_fp8(rv[i][w], 1.0f, false)); b0[2 * w + 1] = __builtin_bit_cast(unsigned, __builtin_amdgcn_cvt_scalef32_pk_bf16_fp8(rv[i][w], 1.0f, true));
                b1[2 * w] = __builtin_bit_cast(unsigned, __builtin_amdgcn_cvt_scalef32_pk_bf16_fp8(rv[i][2 + w], 1.0f, false)); b1[2 * w + 1] = __builtin_bit_cast(unsigned, __builtin_amdgcn_cvt_scalef32_pk_bf16_fp8(rv[i][2 + w], 1.0f, true)); }
            LAS bf16* kd = kt + (r8 + 8 * i) * LVA + 16 * c8; LAS bf16* vd = vt + (r8 + 8 * i) * LVA + 16 * c8;
            *(LAS v4u*)kd = a0; *(LAS v4u*)(kd + 8) = a1; *(LAS v4u*)vd = b0; *(LAS v4u*)(vd + 8) = b1; }
        { const int sn = st + 1 < nst ? st + 1 : st;
#pragma unroll
          for (int i = 0; i < 4; ++i) { const unsigned ro = (unsigned)(ksm[32 * sn + r8 + 8 * i] * 512) + coff; rk[i] = *(const GAS v4u*)(K8 + ro); rv[i] = *(const GAS v4u*)(V8 + ro); } }
        f32x4 l0 = {0.f, 0.f, 0.f, 0.f}, l1 = {0.f, 0.f, 0.f, 0.f};
#pragma unroll
        for (int ks = 0; ks < 4; ++ks) { const bf16x8 A0 = *(const LAS bf16x8*)(kt + c16 * LVA + 32 * ks + 8 * q4), A1 = *(const LAS bf16x8*)(kt + (16 + c16) * LVA + 32 * ks + 8 * q4);
            l0 = MFMA16(A0, Bq[ks], l0); l1 = MFMA16(A1, Bq[ks], l1); }
        float mx = -1e30f;
#pragma unroll
        for (int rg = 0; rg < 4; ++rg) { const int k0 = 32 * st + 4 * q4 + rg; l0[rg] = k0 < nk ? l0[rg] * (RSQ_DK * 0.0625f) : -1e30f; l1[rg] = k0 + 16 < nk ? l1[rg] * (RSQ_DK * 0.0625f) : -1e30f; mx = fmaxf(mx, fmaxf(l0[rg], l1[rg])); }
        mx = fmaxf(mx, __shfl_xor(mx, 16)); mx = fmaxf(mx, __shfl_xor(mx, 32));
        const float mn = fmaxf(m, mx), alpha = __expf(m - mn); m = mn;
        float e[8], ps = 0.f;
#pragma unroll
        for (int rg = 0; rg < 4; ++rg) { e[rg] = __expf(l0[rg] - mn); e[4 + rg] = __expf(l1[rg] - mn); ps += e[rg] + e[4 + rg]; }
        ssum = ssum * alpha + ps;
        v4u pw; pw.x = pk2(e[0], e[1]); pw.y = pk2(e[2], e[3]); pw.z = pk2(e[4], e[5]); pw.w = pk2(e[6], e[7]); const bf16x8 Ap = __builtin_bit_cast(bf16x8, pw);
        float al[4];
#pragma unroll
        for (int rg = 0; rg < 4; ++rg) al[rg] = __uint_as_float((unsigned)__builtin_amdgcn_readlane((int)__float_as_uint(alpha), rg));
#pragma unroll
        for (int dt = 0; dt < 8; ++dt) { const s16x4 r0 = __builtin_amdgcn_ds_read_tr16_b64_v4i16((LAS s16x4*)(trp + 16 * dt)), r1 = __builtin_amdgcn_ds_read_tr16_b64_v4i16((LAS s16x4*)(trp + 16 * LVA + 16 * dt));
            const bf16x8 Bv = __builtin_shufflevector(r0, r1, 0, 1, 2, 3, 4, 5, 6, 7);
            f32x4 oc = o[dt];
#pragma unroll
            for (int rg = 0; rg < 4; ++rg) oc[rg] *= al[rg];
            o[dt] = MFMA16(Ap, Bv, oc); }
    }
    ssum += __shfl_xor(ssum, 16); ssum += __shfl_xor(ssum, 32);
    float inv[4];
#pragma unroll
    for (int rg = 0; rg < 4; ++rg) inv[rg] = 0.0625f / __shfl(ssum, rg);
    LAS bf16* ob = kt;
    if (q4 == 0) {
#pragma unroll
        for (int rg = 0; rg < 4; ++rg)
#pragma unroll
            for (int dt = 0; dt < 8; ++dt) ob[rg * 128 + 16 * dt + c16] = (bf16)f2bf(o[dt][rg] * inv[rg]);
    }
    const v4u ov = *(const LAS v4u*)(ob + q4 * 128 + 8 * c16);
    *(GAS v4u*)(MIXO + (size_t)t * D + (4 * g + q4) * 128 + 8 * c16) = ov;
}
#define AT_CVT(dst, src) do { _Pragma("unroll") for (int w_ = 0; w_ < 2; ++w_) { \
    (dst##0)[2 * w_] = __builtin_bit_cast(unsigned, __builtin_amdgcn_cvt_scalef32_pk_bf16_fp8((src)[w_], 1.0f, false)); (dst##0)[2 * w_ + 1] = __builtin_bit_cast(unsigned, __builtin_amdgcn_cvt_scalef32_pk_bf16_fp8((src)[w_], 1.0f, true)); \
    (dst##1)[2 * w_] = __builtin_bit_cast(unsigned, __builtin_amdgcn_cvt_scalef32_pk_bf16_fp8((src)[2 + w_], 1.0f, false)); (dst##1)[2 * w_ + 1] = __builtin_bit_cast(unsigned, __builtin_amdgcn_cvt_scalef32_pk_bf16_fp8((src)[2 + w_], 1.0f, true)); } } while (0)
#define AT_WRITE(TB, R) do { _Pragma("unroll") for (int i_ = 0; i_ < 4; ++i_) { v4u a0, a1; AT_CVT(a, (R)[i_]); LAS bf16* d_ = (TB) + (r8 + 8 * i_) * LVA + 16 * c8; *(LAS v4u*)d_ = a0; *(LAS v4u*)(d_ + 8) = a1; } } while (0)
#define AT_WRITE_K8(TB, R) do { _Pragma("unroll") for (int i_ = 0; i_ < 4; ++i_) *(LAS v4u*)((LAS unsigned char*)(TB) + (r8 + 8 * i_) * 144 + 16 * c8) = (R)[i_]; } while (0)
#define AT_F8FRAG(dst, p) do { const v2u w_ = *(const LAS v2u*)(p); v4u t_; t_[0] = __builtin_bit_cast(unsigned, __builtin_amdgcn_cvt_scalef32_pk_bf16_fp8(w_[0], 1.0f, false)); t_[1] = __builtin_bit_cast(unsigned, __builtin_amdgcn_cvt_scalef32_pk_bf16_fp8(w_[0], 1.0f, true)); \
    t_[2] = __builtin_bit_cast(unsigned, __builtin_amdgcn_cvt_scalef32_pk_bf16_fp8(w_[1], 1.0f, false)); t_[3] = __builtin_bit_cast(unsigned, __builtin_amdgcn_cvt_scalef32_pk_bf16_fp8(w_[1], 1.0f, true)); (dst) = __builtin_bit_cast(bf16x8, t_); } while (0)
#define AT_QK8(TB, ST) do { f32x4 l0 = {0.f, 0.f, 0.f, 0.f}, l1 = {0.f, 0.f, 0.f, 0.f}; const LAS unsigned char* kb_ = (const LAS unsigned char*)(TB); \
    _Pragma("unroll") for (int ks = 0; ks < 4; ++ks) { const long A0 = *(const LAS long*)(kb_ + c16 * 144 + 32 * ks + 8 * q4), A1 = *(const LAS long*)(kb_ + (16 + c16) * 144 + 32 * ks + 8 * q4);        \
        l0 = __builtin_amdgcn_mfma_f32_16x16x32_fp8_fp8(A0, Bq[ks], l0, 0, 0, 0); l1 = __builtin_amdgcn_mfma_f32_16x16x32_fp8_fp8(A1, Bq[ks], l1, 0, 0, 0); } \
    lg[2 * (ST)] = l0; lg[2 * (ST) + 1] = l1; } while (0)
#define AT_Q8(dst, z) do { const v4u w_ = __builtin_bit_cast(v4u, (z)); \
    int a_ = __builtin_amdgcn_cvt_pk_fp8_f32(lo16(w_[0]) * 4.f, hi16(w_[0]) * 4.f, 0, false); a_ = __builtin_amdgcn_cvt_pk_fp8_f32(lo16(w_[1]) * 4.f, hi16(w_[1]) * 4.f, a_, true); \
    int b_ = __builtin_amdgcn_cvt_pk_fp8_f32(lo16(w_[2]) * 4.f, hi16(w_[2]) * 4.f, 0, false); b_ = __builtin_amdgcn_cvt_pk_fp8_f32(lo16(w_[3]) * 4.f, hi16(w_[3]) * 4.f, b_, true); \
    (dst) = (long)(((unsigned long long)(unsigned)b_ << 32) | (unsigned long long)(unsigned)a_); } while (0)
#define AT_LOAD(R, BASE, KS, STEP) do { _Pragma("unroll") for (int i_ = 0; i_ < 4; ++i_) { const unsigned ro_ = (unsigned)(KS)[32 * (STEP) + r8 + 8 * i_] * 512u + coff; (R)[i_] = *(const GAS v4u*)((BASE) + ro_); } \
    __builtin_amdgcn_sched_barrier(0); } while (0)
#define AT_QK(TB, ST) do { f32x4 l0 = {0.f, 0.f, 0.f, 0.f}, l1 = {0.f, 0.f, 0.f, 0.f}; \
    _Pragma("unroll") for (int ks = 0; ks < 4; ++ks) { const bf16x8 A0 = *(const LAS bf16x8*)((TB) + c16 * LVA + 32 * ks + 8 * q4), A1 = *(const LAS bf16x8*)((TB) + (16 + c16) * LVA + 32 * ks + 8 * q4); l0 = MFMA16(A0, Bq[ks], l0); l1 = MFMA16(A1, Bq[ks], l1); } \
    lg[2 * (ST)] = l0; lg[2 * (ST) + 1] = l1; } while (0)
#define AT_PV(TB, ST) do { const LAS bf16* trp_ = (TB) + (4 * q4 + (c16 >> 2)) * LVA + 4 * (c16 & 3); \
    _Pragma("unroll") for (int dt = 0; dt < 8; ++dt) { const s16x4 r0 = __builtin_amdgcn_ds_read_tr16_b64_v4i16((LAS s16x4*)(trp_ + 16 * dt)), r1 = __builtin_amdgcn_ds_read_tr16_b64_v4i16((LAS s16x4*)(trp_ + 16 * LVA + 16 * dt)); \
        const bf16x8 Bv = __builtin_shufflevector(r0, r1, 0, 1, 2, 3, 4, 5, 6, 7); o[dt] = MFMA16(Ap[ST], Bv, o[dt]); } } while (0)
#define AT_PV8(TB, ST) do { const LAS unsigned char* vb_ = (const LAS unsigned char*)(TB) + (4 * q4 + (c16 >> 2)) * 144 + 8 * (c16 & 3); \
    _Pragma("unroll") for (int dg = 0; dg < 4; ++dg) { const s16x4 r0 = __builtin_amdgcn_ds_read_tr16_b64_v4i16((LAS s16x4*)(vb_ + 32 * dg)), r1 = __builtin_amdgcn_ds_read_tr16_b64_v4i16((LAS s16x4*)(vb_ + 16 * 144 + 32 * dg)); \
        const v2u a_ = __builtin_bit_cast(v2u, r0), b_ = __builtin_bit_cast(v2u, r1); \
        const unsigned e0 = __builtin_amdgcn_perm(a_[1], a_[0], 0x06040200u), o0 = __builtin_amdgcn_perm(a_[1], a_[0], 0x07050301u), e1 = __builtin_amdgcn_perm(b_[1], b_[0], 0x06040200u), o1 = __builtin_amdgcn_perm(b_[1], b_[0], 0x07050301u); \
        v4u fe, fo; fe[0] = __builtin_bit_cast(unsigned, __builtin_amdgcn_cvt_scalef32_pk_bf16_fp8(e0, 1.0f, false)); fe[1] = __builtin_bit_cast(unsigned, __builtin_amdgcn_cvt_scalef32_pk_bf16_fp8(e0, 1.0f, true)); \
        fe[2] = __builtin_bit_cast(unsigned, __builtin_amdgcn_cvt_scalef32_pk_bf16_fp8(e1, 1.0f, false)); fe[3] = __builtin_bit_cast(unsigned, __builtin_amdgcn_cvt_scalef32_pk_bf16_fp8(e1, 1.0f, true)); \
        fo[0] = __builtin_bit_cast(unsigned, __builtin_amdgcn_cvt_scalef32_pk_bf16_fp8(o0, 1.0f, false)); fo[1] = __builtin_bit_cast(unsigned, __builtin_amdgcn_cvt_scalef32_pk_bf16_fp8(o0, 1.0f, true)); \
        fo[2] = __builtin_bit_cast(unsigned, __builtin_amdgcn_cvt_scalef32_pk_bf16_fp8(o1, 1.0f, false)); fo[3] = __builtin_bit_cast(unsigned, __builtin_amdgcn_cvt_scalef32_pk_bf16_fp8(o1, 1.0f, true)); \
        o[2 * dg] = MFMA16(Ap[ST], __builtin_bit_cast(bf16x8, fe), o[2 * dg]); o[2 * dg + 1] = MFMA16(Ap[ST], __builtin_bit_cast(bf16x8, fo), o[2 * dg + 1]); } } while (0)
#define AT_GRAB(dst) do { int b_ = 0; if (lane == 0) b_ = (int)xb_add(ctr, 4u); (dst) = __builtin_amdgcn_readfirstlane(b_); } while (0)
#define AT_ISSUE() do { pend = 0; if (lane == 0) pend = (int)xb_add(ctr, 4u); } while (0)
#define AT_TAKE(dst) do { (dst) = __builtin_amdgcn_readfirstlane(pend); } while (0)
__device__ __forceinline__ void phase_attn(ArgsP ap, LW lds_, int jl) {
    const CONSTAS Args& a = *ap; const Ctx c = make_ctx(lds_); GAS unsigned char* ws = opaque_ws(a.ws); const GAS bf16* PROJ = (const GAS bf16*)(ws + WS_PROJ); const GAS unsigned short* SEL = (const GAS unsigned short*)(ws + WS_SEL); GAS bf16* MIXO = (GAS bf16*)(ws + WS_MIXO); const GAS unsigned char* K8 = ws + WS_K8; const GAS unsigned char* V8 = ws + WS_V8;
    GAS unsigned* acnt = (GAS unsigned*)(ws + WS_CTL) + CW_ACNT + 64 * jl;
    LAS bf16* kt = (LAS bf16*)(c.lds + c.wave * 19456); LAS bf16* vt = kt + 32 * LVA; LAS unsigned short* ksm = (LAS unsigned short*)(kt + 64 * LVA);
    const int lane = c.lane, c16 = lane & 15, q4 = lane >> 4, r8 = lane >> 3, c8 = lane & 7; const int x = (int)(xb_xcc_id() & 7u);
    const GAS char* pb = (const GAS char*)PROJ;
    for (int pp = 0; pp < 8; ++pp) { const int pool = (x + pp) & 7, g = pool & 3, half = pool >> 2; GAS unsigned* ctr = acnt + pool; const int QF = half ? T / 2 - 256 : T / 2;        const unsigned coff = (unsigned)(g * 128 + 16 * c8);
#define AT_TQ(q) ((half ? T / 2 - 1 : T - 1) - (q))
        int nb; AT_GRAB(nb);
        if (nb < QF) {
            int cb = nb, ci = 0, pend = 0; AT_ISSUE();
            int t = AT_TQ(cb); LAS unsigned short* ksc = ksm; LAS unsigned short* ksn = ksm + 256;
#pragma unroll
            for (int i = 0; i < 4; ++i) ksc[lane + 64 * i] = SEL[(size_t)t * 256 + lane + 64 * i];
            long Bq[4];
#pragma unroll
            for (int ks = 0; ks < 4; ++ks) { bf16x8 z = {0, 0, 0, 0, 0, 0, 0, 0}; if (c16 < 4) z = *(const GAS bf16x8*)(pb + (unsigned)((t * NO + OC_Q + (4 * g + c16) * 128 + 32 * ks + 8 * q4) * 2)); AT_Q8(Bq[ks], z); }
            v4u s0[4], s1[4], s2[4], s3[4];
            AT_LOAD(s0, K8, ksc, 0); AT_LOAD(s1, K8, ksc, 1); AT_LOAD(s2, K8, ksc, 2); AT_LOAD(s3, K8, ksc, 3);
            for (;;) {
                if (ci == 3) AT_TAKE(nb);
                const bool has_next = (ci < 3) || (nb < QF); const int tn = has_next ? AT_TQ(ci < 3 ? cb + ci + 1 : nb) : t;
                f32x4 lg[16]; unsigned short kreg[4]; long Bqn[4];
                AT_WRITE_K8(kt, s0); AT_LOAD(s0, K8, ksc, 4);
#pragma unroll
                for (int i = 0; i < 4; ++i) kreg[i] = SEL[(size_t)tn * 256 + lane + 64 * i];
                AT_QK8(kt, 0);
                AT_WRITE_K8(vt, s1); AT_LOAD(s1, K8, ksc, 5); AT_QK8(vt, 1);
                AT_WRITE_K8(kt, s2); AT_LOAD(s2, K8, ksc, 6); AT_QK8(kt, 2);
                AT_WRITE_K8(vt, s3); AT_LOAD(s3, K8, ksc, 7); AT_QK8(vt, 3);
                AT_WRITE_K8(kt, s0); AT_LOAD(s0, V8, ksc, 0); AT_QK8(kt, 4);
                AT_WRITE_K8(vt, s1); AT_LOAD(s1, V8, ksc, 1); AT_QK8(vt, 5);
                AT_WRITE_K8(kt, s2); AT_LOAD(s2, V8, ksc, 2);
#pragma unroll
                for (int i = 0; i < 4; ++i) ksn[lane + 64 * i] = kreg[i];
                AT_QK8(kt, 6);
                AT_WRITE_K8(vt, s3); AT_LOAD(s3, V8, ksc, 3); AT_QK8(vt, 7);
                float m = -1e30f;
#pragma unroll
                for (int kk = 0; kk < 16; ++kk)
#pragma unroll
                    for (int rg = 0; rg < 4; ++rg) m = fmaxf(m, lg[kk][rg]);
                m = fmaxf(m, __shfl_xor(m, 16)); m = fmaxf(m, __shfl_xor(m, 32));
                float ssum = 0.f; bf16x8 Ap[8]; const float sc = RSQ_DK * 0.015625f; const float msc = m * sc;
#pragma unroll
                for (int ks2 = 0; ks2 < 8; ++ks2) { float e[8];
#pragma unroll
                    for (int j = 0; j < 8; ++j) { e[j] = __expf(lg[2 * ks2 + (j >> 2)][j & 3] * sc - msc); ssum += e[j]; }
                    v4u pw; pw.x = pk2(e[0], e[1]); pw.y = pk2(e[2], e[3]); pw.z = pk2(e[4], e[5]); pw.w = pk2(e[6], e[7]); Ap[ks2] = __builtin_bit_cast(bf16x8, pw); __builtin_amdgcn_sched_barrier(0); }
                ssum += __shfl_xor(ssum, 16); ssum += __shfl_xor(ssum, 32);
                f32x4 o[8];
#pragma unroll
                for (int dt = 0; dt < 8; ++dt) o[dt] = (f32x4){0.f, 0.f, 0.f, 0.f};
                AT_WRITE_K8(kt, s0); AT_LOAD(s0, V8, ksc, 4); AT_PV8(kt, 0);
                AT_WRITE_K8(vt, s1); AT_LOAD(s1, V8, ksc, 5);
                AT_PV8(vt, 1);
                AT_WRITE_K8(kt, s2); AT_LOAD(s2, V8, ksc, 6); AT_PV8(kt, 2);
                AT_WRITE_K8(vt, s3); AT_LOAD(s3, V8, ksc, 7); AT_PV8(vt, 3);
                AT_WRITE_K8(kt, s0); AT_LOAD(s0, K8, ksn, 0); AT_PV8(kt, 4);
                AT_WRITE_K8(vt, s1); AT_LOAD(s1, K8, ksn, 1);
#pragma unroll
                for (int ks = 0; ks < 4; ++ks) { bf16x8 z = {0, 0, 0, 0, 0, 0, 0, 0}; if (c16 < 4) z = *(const GAS bf16x8*)(pb + (unsigned)((tn * NO + OC_Q + (4 * g + c16) * 128 + 32 * ks + 8 * q4) * 2)); AT_Q8(Bqn[ks], z); }
                AT_PV8(vt, 5);
                AT_WRITE_K8(kt, s2); AT_LOAD(s2, K8, ksn, 2); AT_PV8(kt, 6);
                AT_WRITE_K8(vt, s3); AT_LOAD(s3, K8, ksn, 3); AT_PV8(vt, 7);
                float inv[4];
#pragma unroll
                for (int rg = 0; rg < 4; ++rg) inv[rg] = 0.0625f / __shfl(ssum, rg);
                if (q4 == 0) {
#pragma unroll
                    for (int rg = 0; rg < 4; ++rg)
#pragma unroll
                        for (int dt = 0; dt < 8; ++dt) kt[rg * 128 + 32 * (dt >> 1) + 2 * c16 + (dt & 1)] = (bf16)f2bf(o[dt][rg] * inv[rg]);
                }
                const v4u ov = *(const LAS v4u*)(kt + q4 * 128 + 8 * c16);
                *(GAS v4u*)(MIXO + (size_t)t * D + (4 * g + q4) * 128 + 8 * c16) = ov;
                if (!has_next) break;
#pragma unroll
                for (int ks = 0; ks < 4; ++ks) Bq[ks] = Bqn[ks];
                t = tn; { LAS unsigned short* tmp = ksc; ksc = ksn; ksn = tmp; }
                if (ci < 3) ++ci; else { cb = nb; ci = 0; AT_ISSUE(); }
            }
        }
        while (nb < T / 2) { for (int q = nb; q < nb + 4; ++q) attn_task(PROJ, K8, V8, SEL, MIXO, kt, vt, ksm, AT_TQ(q), g, lane); AT_GRAB(nb); }
#undef AT_TQ
    }
}

constexpr int N_PHASES = 1 + 10 * DEPTH;
#ifndef PHASE_MASK
#define PHASE_MASK 0xFFFF
#endif
#define EN(k) ((PHASE_MASK >> (k)) & 1)
#ifndef REP_MASK
#define REP_MASK 0
#endif
#define REPS(k) for (int rep_ = 0; rep_ < 1 + ((REP_MASK >> (k)) & 1); ++rep_)
__global__ void __launch_bounds__(NTHR, 2) fwd(Args a) {
    extern __shared__ __attribute__((aligned(16))) unsigned char lds_raw[];
    int wave_s_ = __builtin_amdgcn_readfirstlane((int)(threadIdx.x >> 6)); asm volatile("" : "+s"(wave_s_)); const int wave_s = wave_s_;
    LW lds; lds.p = (LAS unsigned char*)lds_raw; lds.w = wave_s;
#define LEADER() (wave_s == 0 && lane_id() == 0)
    volatile LAS unsigned* xbw = (volatile LAS unsigned*)(lds.p + LDS_BYTES - 64);
    if (threadIdx.x < 16) xbw[threadIdx.x] = 0u;
    __syncthreads();
    GAS unsigned char* const ws0 = (GAS unsigned char*)a.ws;
    XcdBarrier bar; bar.bar = (GAS unsigned*)(ws0 + WS_CTL) + CW_BAR; bar.x = 0; bar.st = xbw;
    const int lo = a.ph_lo, hi = a.ph_hi;
    if (hi - lo > 1) bar = xcd_barrier_post((GAS unsigned*)(ws0 + WS_CTL) + CW_BAR, xbw, LEADER());
#define IN(k) (lo <= (k) && (k) < hi)
#define SEAM(k) do { if (IN(k) && IN((k) + 1)) { XcdBarrier b2_ = bar; b2_.bar = (GAS unsigned*)opaque_ws((const void*)bar.bar); xcd_barrier(b2_, LEADER()); } } while (0)
    if (EN(0) && IN(0)) REPS(0) { phase_prologue(opaque_args(), lds); } SEAM(0);
    for (int L = 0; L < DEPTH; ++L) {
        const int base = 1 + 10 * L, jl = L >> 1; const bool even = (L & 1) == 0; GAS unsigned char* ws = opaque_ws(a.ws);
        if (EN(1) && IN(base)) REPS(1) {
            const int N = even ? NE : NO;
            pg8::Gemm g{(const pg8::bf16_t*)(ws + WS_HB), (const pg8::bf16_t*)(ws + (even ? WS_WINE : WS_WINO)) + (size_t)jl * N * D, T, N, D};
            pg8::StaticOrder S; S.init(T, N, (int)gridDim.x, (int)blockIdx.x);
            pg8::EpiProj E{(PG8_GAS pg8::bf16_t*)(ws + WS_PROJ), N, N / 256 - 1, (PG8_GAS float*)(ws + WS_SMALL)};
            pg8::gemm_phase<pg8::EpiProj, pg8::StaticOrder, false>((PG8_LAS unsigned char*)lds.p, g, S, E, nullptr, wave_s);
        }
        SEAM(base);
        if (even) {
            if (EN(2) && IN(base + 1)) REPS(2) phase_chunk_a(opaque_args(), lds, jl);
            SEAM(base + 1);
            if (EN(3) && IN(base + 2)) phase_scan(opaque_args(), lds);
            SEAM(base + 2);
            if (EN(4) && IN(base + 3)) REPS(4) phase_chunk_c(opaque_args(), lds, jl);
            SEAM(base + 3);
        } else {
            if (EN(5) && IN(base + 1)) phase_rope(opaque_args(), lds);
            SEAM(base + 1);
            if (EN(6) && IN(base + 2)) REPS(6) phase_index(opaque_args(), lds);
            SEAM(base + 2);
            if (EN(7) && IN(base + 3)) phase_attn(opaque_args(), lds, jl);
            SEAM(base + 3);
        }
        if (EN(8) && IN(base + 4)) REPS(8) {
            pg8::Gemm g{(const pg8::bf16_t*)(ws + WS_MIXO), (const pg8::bf16_t*)(ws + WS_WOUT) + (size_t)((even ? 0 : 2) + jl) * D * D, T, D, D};
            pg8::StaticOrder S; S.init(T, D, (int)gridDim.x, (int)blockIdx.x);
            pg8::EpiPlain E{(PG8_GAS pg8::bf16_t*)(ws + WS_MIX), D, 8};
            pg8::gemm_phase<pg8::EpiPlain, pg8::StaticOrder, false>((PG8_LAS unsigned char*)lds.p, g, S, E, nullptr, wave_s);
        }
        SEAM(base + 4);
        if (EN(9) && IN(base + 5)) phase_ln<0>(opaque_args(), lds, L);
        SEAM(base + 5);
        if ((EN(11) && IN(base + 7)) || (EN(12) && IN(base + 8))) {
            const GAS unsigned* cnt = (const GAS unsigned*)(ws + WS_CTL) + CW_CNT + 64 * L;
            pg8::MoeOrder S; { int acc = 0;
#pragma unroll
                for (int e = 0; e < 16; ++e) { S.toff[e] = acc; S.cnt[e] = (int)__builtin_amdgcn_readfirstlane((int)cnt[e]); acc += (S.cnt[e] + 255) >> 8; } S.toff[16] = acc; }
            S.list = (const PG8_GAS int*)(ws + WS_LIST); S.ldl = T;
            S.G = (int)gridDim.x; S.c = (int)blockIdx.x;
            if (EN(11) && IN(base + 7)) REPS(11) { S.ncol = 4;
                pg8::Gemm g{(const pg8::bf16_t*)(ws + WS_HB), (const pg8::bf16_t*)(ws + WS_WGU) + (size_t)L * 16 * 1024 * D, XROWS, 1024, D};
                pg8::EpiGU E{(PG8_GAS pg8::bf16_t*)(ws + WS_HMID), (const PG8_GAS float*)(ws + WS_GLIST), T};
                pg8::gemm_phase<pg8::EpiGU, pg8::MoeOrder, false, true>((PG8_LAS unsigned char*)lds.p, g, S, E, nullptr, wave_s); }
            SEAM(base + 7);
            if (EN(12) && IN(base + 8)) REPS(12) { S.ncol = 8;
                pg8::Gemm g{(const pg8::bf16_t*)(ws + WS_HMID), (const pg8::bf16_t*)(ws + WS_WDN) + (size_t)L * 16 * D * 512, XROWS, D, 512};
                pg8::EpiF8 E{(PG8_GAS unsigned char*)(ws + WS_Y), D, 8};
                pg8::gemm_phase<pg8::EpiF8, pg8::MoeOrder, false>((PG8_LAS unsigned char*)lds.p, g, S, E, nullptr, wave_s); }
        }
        SEAM(base + 8);
        if (EN(13) && IN(base + 9)) phase_ln<1>(opaque_args(), lds, L);
        SEAM(base + 9);
    }
#undef IN
#undef SEAM
}

#ifndef N_LAUNCH_MODE
#define N_LAUNCH_MODE 1
#endif
extern "C" void kernel_launch(void* const* d_in, const int* in_sizes, int n_in, void* d_out, int out_size, void* d_ws, size_t ws_size, hipStream_t stream) {
    static int grid = 0;
    if (grid == 0) {
        if (n_in != 22 || out_size != T * D || ws_size < WS_END) { fprintf(stderr, "kernel_launch: unexpected shapes (n_in %d out %d ws %zu need %zu)\n", n_in, out_size, ws_size, (size_t)WS_END); grid = -1; return; }
        int dev = 0, cus = 0, per_cu = 0;
        if (hipGetDevice(&dev) != hipSuccess || hipDeviceGetAttribute(&cus, hipDeviceAttributeMultiprocessorCount, dev) != hipSuccess) { grid = -1; return; }
        if (hipFuncSetAttribute((const void*)fwd, hipFuncAttributeMaxDynamicSharedMemorySize, LDS_BYTES) != hipSuccess) { fprintf(stderr, "kernel_launch: hipFuncSetAttribute failed\n"); grid = -1; return; }
        if (hipOccupancyMaxActiveBlocksPerMultiprocessor(&per_cu, (const void*)fwd, NTHR, LDS_BYTES) != hipSuccess || per_cu < 1) fprintf(stderr, "kernel_launch: occupancy query says %d\n", per_cu);
        (void)hipGetLastError();
        grid = cus;
    }
    if (grid < 0) return;
    (void)hipMemsetAsync((char*)d_ws + WS_CTL, 0, CTL_ZERO_BYTES, stream);
    Args a{};
    a.x = (const float*)d_in[0]; a.pos = (const int*)d_in[1]; a.ab_w_in = (const float*)d_in[2]; a.ab_conv_w = (const float*)d_in[3]; a.ab_igate_b = (const float*)d_in[4]; a.ab_fgate_b = (const float*)d_in[5];
    a.ab_gla_w2 = (const float*)d_in[6]; a.ab_gla_b = (const float*)d_in[7]; a.ab_mnorm = (const float*)d_in[8]; a.ab_gnorm = (const float*)d_in[9]; a.ab_w_out = (const float*)d_in[10];
    a.c_w_in = (const float*)d_in[11]; a.c_w_out = (const float*)d_in[12]; a.router_w = (const float*)d_in[13]; a.router_b = (const float*)d_in[14];
    a.moe_gate = (const float*)d_in[15]; a.moe_up = (const float*)d_in[16]; a.moe_down = (const float*)d_in[17];
    a.ln_mix_g = (const float*)d_in[18]; a.ln_mix_b = (const float*)d_in[19]; a.ln_ffn_g = (const float*)d_in[20]; a.ln_ffn_b = (const float*)d_in[21];
    a.out = (float*)d_out; a.ws = (unsigned char*)d_ws;
#if N_LAUNCH_MODE == 1
    a.ph_lo = 0; a.ph_hi = N_PHASES;
    hipLaunchKernelGGL(fwd, dim3(grid), dim3(NTHR), LDS_BYTES, stream, a);
#else
    for (int p = 0; p < N_PHASES; ++p) { a.ph_lo = p; a.ph_hi = p + 1; hipLaunchKernelGGL(fwd, dim3(grid), dim3(NTHR), LDS_BYTES, stream, a); }
#endif
}
```

```cpp
#include <hip/hip_runtime.h>
#include <cstdio>
#include <cstdint>
namespace pg8 {
#define PG8_LAS __attribute__((address_space(3)))
#define PG8_GAS __attribute__((address_space(1)))
typedef unsigned short bf16_t;
typedef short bf16x8 __attribute__((ext_vector_type(8)));
typedef float f32x4 __attribute__((ext_vector_type(4)));
typedef unsigned u32x4 __attribute__((ext_vector_type(4)));
constexpr int BM = 256, BK = 64, HALF = 128, HTB = HALF * BK * 2  , STAGE_BYTES = 8 * HTB, NXCD = 8, WGM = 4;

__host__ __device__ __forceinline__ int lds_byte(int r, int c) { const int st = (r >> 4) * 2 + (c >> 5), rr = r & 15, cc = c & 31, ob = rr * 64 + cc * 2; return st * 1024 + (ob ^ (((ob >> 9) & 1) << 5)); }
__host__ __device__ __forceinline__ void stage_rc(int b, int& R, int& C) { const int st = b / 1024, sb = b % 1024, swz = sb ^ (((sb >> 9) & 1) << 5); R = (st >> 1) * 16 + swz / 64; C = (st & 1) * 32 + (swz % 64) / 2; }
__host__ __device__ __forceinline__ int perm32(int rho) { const int n = rho >> 4, i = rho & 15; return 8 * (i >> 2) + 4 * n + (i & 3); }

struct Unit { int pm, pn; int e, seg0, cnt; };
struct Gemm { const bf16_t* A; const bf16_t* Bt; int M, N, K; };

struct StaticOrder {
    int nM, nN, nwg, G, c;
    __host__ __device__ void init(int M, int N, int G_, int c_) { nM = M / BM; nN = N / BM; nwg = nM * nN; G = G_; c = c_; }
    __host__ __device__ bool next(int i, Unit& u) const {
        const long L = (long)i * G + c; if (L >= nwg) return false;
        int wgid = (int)L; { const int q = nwg / NXCD, r = nwg % NXCD, xcd = wgid % NXCD, off = wgid / NXCD; wgid = (xcd < r ? xcd * (q + 1) : r * (q + 1) + (xcd - r) * q) + off; }
        const int nig = WGM * nN, gid = wgid / nig, fm = gid * WGM, gsz = (nM - fm) < WGM ? (nM - fm) : WGM;
        u.pm = fm + ((wgid % nig) % gsz); u.pn = (wgid % nig) / gsz; return true;
    }
    __device__ __forceinline__ void a_ready(const Unit&) const {}
    __device__ __forceinline__ void done(const Unit&) const {}
    __device__ __forceinline__ int src_row(const Unit&, int row) const { return row; }
};
__device__ __forceinline__ unsigned cvt_pk_bf16(float lo, float hi) { unsigned r; asm volatile("v_cvt_pk_bf16_f32 %0, %1, %2" : "=v"(r) : "v"(lo), "v"(hi)); return r; }
typedef float f32x2 __attribute__((ext_vector_type(2)));
__device__ __forceinline__ f32x2 gelu_pk(f32x2 v) {
    const f32x2 av = __builtin_elementwise_abs(v), d = av * 0.2316418882f + 1.0f;
    f32x2 t; t.x = __builtin_amdgcn_rcpf(d.x); t.y = __builtin_amdgcn_rcpf(d.y);
    f32x2 q = t * 0.5307027145f + (-0.7265760135f); q = q * t + 0.7107068705f; q = q * t + (-0.142248368f); q = q * t + 0.127414796f; q = q * t;
    const f32x2 s = (v * v) * (-0.72134752044f);
    f32x2 e; e.x = __builtin_amdgcn_exp2f(s.x); e.y = __builtin_amdgcn_exp2f(s.y);
    const f32x2 m = v * (q * e), r = v - m;
    f32x2 o; o.x = v.x < 0.f ? m.x : r.x; o.y = v.y < 0.f ? m.y : r.y; return o;
}


__device__ __forceinline__ u32x4 pack8(const f32x4 v0, const f32x4 v1) { u32x4 w; w.x = cvt_pk_bf16(v0[0], v0[1]); w.y = cvt_pk_bf16(v0[2], v0[3]); w.z = cvt_pk_bf16(v1[0], v1[1]); w.w = cvt_pk_bf16(v1[2], v1[3]); return w; }
struct EpiProj {
    static constexpr bool PERM = true, AFTER_DRAIN = false;
    PG8_GAS bf16_t* O; int ldc; int last_pn; PG8_GAS float* small;
    __device__ __forceinline__ void operator()(const f32x4 (&acc)[2][2][4][2], const Unit& u, int wr, int wc, int fr, int fq) const {
        const int row0 = u.pm * BM + wr * 64 + fr, col0 = u.pn * BM + wc * 32 + 8 * fq; const bool sm = (u.pn == last_pn);
#pragma unroll
        for (int ai = 0; ai < 2; ++ai)
#pragma unroll
            for (int m = 0; m < 4; ++m) { const int row = row0 + ai * HALF + m * 16; PG8_GAS bf16_t* rowp = O + (size_t)row * ldc + col0;
#pragma unroll
                for (int bj = 0; bj < 2; ++bj) *(PG8_GAS u32x4*)(rowp + bj * HALF) = pack8(acc[ai][bj][m][0], acc[ai][bj][m][1]);
                if (sm) { PG8_GAS float* sp = small + (size_t)row * 128 + wc * 32 + 8 * fq; *(PG8_GAS f32x4*)sp = acc[ai][0][m][0]; *(PG8_GAS f32x4*)(sp + 4) = acc[ai][0][m][1]; } }
    }
};
struct EpiPlain {
    static constexpr bool PERM = true, AFTER_DRAIN = false;
    PG8_GAS bf16_t* O; int ldc; int pn_mod;
    __device__ __forceinline__ void operator()(const f32x4 (&acc)[2][2][4][2], const Unit& u, int wr, int wc, int fr, int fq) const {
        const int row0 = u.pm * BM + wr * 64 + fr, col0 = (u.pn % pn_mod) * BM + wc * 32 + 8 * fq;
#pragma unroll
        for (int ai = 0; ai < 2; ++ai)
#pragma unroll
            for (int m = 0; m < 4; ++m) { PG8_GAS bf16_t* rowp = O + (size_t)(row0 + ai * HALF + m * 16) * ldc + col0;
#pragma unroll
                for (int bj = 0; bj < 2; ++bj) *(PG8_GAS u32x4*)(rowp + bj * HALF) = pack8(acc[ai][bj][m][0], acc[ai][bj][m][1]); }
    }
};
typedef unsigned u32x2 __attribute__((ext_vector_type(2)));
struct EpiF8 {
    static constexpr bool PERM = true, AFTER_DRAIN = false;
    PG8_GAS unsigned char* O; int ldc; int pn_mod;
    __device__ __forceinline__ void operator()(const f32x4 (&acc)[2][2][4][2], const Unit& u, int wr, int wc, int fr, int fq) const {
        const int row0 = u.pm * BM + wr * 64 + fr, col0 = (u.pn % pn_mod) * BM + wc * 32 + 8 * fq;
#pragma unroll
        for (int ai = 0; ai < 2; ++ai)
#pragma unroll
            for (int m = 0; m < 4; ++m) { PG8_GAS unsigned char* rowp = O + (size_t)(row0 + ai * HALF + m * 16) * ldc + col0;
#pragma unroll
                for (int bj = 0; bj < 2; ++bj) { const f32x4 v0 = acc[ai][bj][m][0], v1 = acc[ai][bj][m][1];
                    int w0 = __builtin_amdgcn_cvt_pk_fp8_f32(v0[0] * 4.f, v0[1] * 4.f, 0, false); w0 = __builtin_amdgcn_cvt_pk_fp8_f32(v0[2] * 4.f, v0[3] * 4.f, w0, true);
                    int w1 = __builtin_amdgcn_cvt_pk_fp8_f32(v1[0] * 4.f, v1[1] * 4.f, 0, false); w1 = __builtin_amdgcn_cvt_pk_fp8_f32(v1[2] * 4.f, v1[3] * 4.f, w1, true);
                    *(PG8_GAS u32x2*)(rowp + bj * HALF) = (u32x2){(unsigned)w0, (unsigned)w1}; } }
    }
};
struct EpiGU {
    static constexpr bool PERM = true, AFTER_DRAIN = false;
    PG8_GAS bf16_t* H; const PG8_GAS float* glist; int ldl;
    __device__ __forceinline__ void operator()(const f32x4 (&acc)[2][2][4][2], const Unit& u, int wr, int wc, int fr, int fq) const {
        const int row0 = u.pm * BM + wr * 64 + fr, col0 = (u.pn & 3) * 128 + wc * 32 + 8 * fq;
        float gts[2][4];
#pragma unroll
        for (int ai = 0; ai < 2; ++ai)
#pragma unroll
            for (int m = 0; m < 4; ++m) { const int s_ = row0 + ai * HALF + m * 16 - u.seg0; const bool ok = s_ < u.cnt; const float v = glist[(size_t)u.e * ldl + (ok ? s_ : 0)]; gts[ai][m] = ok ? v : 0.f; }
#pragma unroll
        for (int ai = 0; ai < 2; ++ai)
#pragma unroll
            for (int m = 0; m < 4; ++m) { const int row = row0 + ai * HALF + m * 16; const float gt = gts[ai][m]; f32x4 h0, h1;
#pragma unroll
                for (int j = 0; j < 4; ++j) { const float g0 = acc[ai][0][m][0][j], g1 = acc[ai][0][m][1][j];
                    h0[j] = g0 * __builtin_amdgcn_rcpf(1.0f + __expf(-g0)) * acc[ai][1][m][0][j] * gt; h1[j] = g1 * __builtin_amdgcn_rcpf(1.0f + __expf(-g1)) * acc[ai][1][m][1][j] * gt; }
                *(PG8_GAS u32x4*)(H + (size_t)row * 512 + col0) = pack8(h0, h1); }
    }
};
struct MoeOrder {
    int toff[17]; int cnt[16]; int ncol, G, c; const PG8_GAS int* list; int ldl;
    __device__ __forceinline__ bool next(int i, Unit& u) const {
        const int L = i * G + c; if (L >= toff[16] * ncol) return false;
        const int pm = L / ncol, pn = L - pm * ncol; int e = 0;
#pragma unroll
        for (int k = 1; k < 16; ++k) e += (toff[k] <= pm) ? 1 : 0;
        int sg = 0, cn = 0;
#pragma unroll
        for (int k = 0; k < 16; ++k) { sg = (k == e) ? toff[k] * BM : sg; cn = (k == e) ? cnt[k] : cn; }
        u.pm = pm; u.pn = e * ncol + pn; u.e = e; u.seg0 = sg; u.cnt = cn; return true;
    }
    __device__ __forceinline__ void a_ready(const Unit&) const {}
    __device__ __forceinline__ void done(const Unit&) const {}
    __device__ __forceinline__ int src_row(const Unit& u, int row) const { const int s = row - u.seg0; const bool ok = s < u.cnt; const int v = list[(size_t)u.e * ldl + (ok ? s : 0)]; return ok ? v : 0; }
};

template <class Epi, class Sched, bool STAMP = false, bool GATHER = false>
__device__ __forceinline__ void gemm_phase(PG8_LAS unsigned char* lds, const Gemm g, const Sched& S, const Epi& E, unsigned long long* stamps, int wave_s) {
    int l0_, w0_ = wave_s; asm volatile("v_mbcnt_lo_u32_b32 %0, -1, 0\n\tv_mbcnt_hi_u32_b32 %0, -1, %0" : "=&v"(l0_));        asm volatile("" : "+s"(w0_)); const int tid_ = w0_ * 64 + l0_; const int tid = tid_, wid = __builtin_amdgcn_readfirstlane(tid >> 6), lane = tid & 63, wr = wid >> 2, wc = wid & 3, fr = lane & 15, fq = lane >> 4;
    const int K = g.K, nt = K / BK;
    int ts_lo = 0, ts_hi = 0, nts = 0; const unsigned long long rt_entry = STAMP ? (unsigned long long)wall_clock64() : 0ull;
#define PG8_STAMP() do { if (STAMP && wid == 0 && nts < 64) { const unsigned long long _c = (unsigned long long)clock64(); \
        ts_lo = (lane == nts) ? (int)(unsigned)_c : ts_lo; ts_hi = (lane == nts) ? (int)(unsigned)(_c >> 32) : ts_hi; ++nts; } } while (0)
    PG8_STAMP();
    unsigned voffA[2], voffB[2]; int RA[2], CA[2];
#pragma unroll
    for (int i = 0; i < 2; ++i) { int R, C; stage_rc(tid * 16 + i * 8192, R, C); const int Rb = Epi::PERM ? ((R & ~31) + perm32(R & 31)) : R; RA[i] = R; CA[i] = C;
        voffA[i] = (unsigned)(R * K + C) * 2u; voffB[i] = (unsigned)(Rb * K + C) * 2u; }
    unsigned cvo[2][2], nvo[2][2];
#pragma unroll
    for (int hh_ = 0; hh_ < 2; ++hh_)
#pragma unroll
        for (int i = 0; i < 2; ++i) { cvo[hh_][i] = voffA[i]; nvo[hh_][i] = voffA[i]; }
    const size_t hstepA = GATHER ? (size_t)0 : (size_t)HALF * K * 2;
#define PG8_ROWS(u, vo) do { _Pragma("unroll") for (int hh_ = 0; hh_ < 2; ++hh_) _Pragma("unroll") for (int i_ = 0; i_ < 2; ++i_) { \
        const int tok_ = S.src_row((u), (u).pm * BM + HALF * hh_ + RA[i_]); (vo)[hh_][i_] = (unsigned)(tok_ * K + CA[i_]) * 2u; } } while (0)
    const size_t kstep = (size_t)(BK * 2);
    const size_t hstep = (size_t)HALF * K * 2;
    const size_t tstep = 2 * hstep;
    const unsigned ldsw = (unsigned)wid * 1024u;
    const int aoff = lds_byte(wr * 64 + fr, fq * 8), boff = lds_byte(wc * 32 + fr, fq * 8);
#define PG8_SA(b, h) (((b) * 2 + (h)) * HTB)
#define PG8_SB(b, h) ((4 + (b) * 2 + (h)) * HTB)
#define PG8_STAGE(bufoff, gbase, voff) do { _Pragma("unroll") for (int _i = 0; _i < 2; ++_i) \
        __builtin_amdgcn_global_load_lds((const unsigned*)((const char*)(gbase) + (voff)[_i]), (PG8_LAS unsigned*)(lds + (bufoff) + ldsw + _i * 8192), 16, 0, 0); } while (0)
#define PG8_LDA(dst, b, h) do { _Pragma("unroll") for (int m = 0; m < 4; ++m) _Pragma("unroll") for (int k = 0; k < 2; ++k) dst[m][k] = *(const PG8_LAS bf16x8*)(lds + PG8_SA(b, h) + aoff + m * 2048 + k * 1024); } while (0)
#define PG8_LDB(dst, b, h) do { _Pragma("unroll") for (int n = 0; n < 2; ++n) _Pragma("unroll") for (int k = 0; k < 2; ++k) dst[n][k] = *(const PG8_LAS bf16x8*)(lds + PG8_SB(b, h) + boff + n * 2048 + k * 1024); } while (0)
#define PG8_MMA(ai, bj, At, Bt) do { __builtin_amdgcn_s_setprio(1); _Pragma("unroll") for (int m = 0; m < 4; ++m) _Pragma("unroll") for (int n = 0; n < 2; ++n) _Pragma("unroll") for (int k = 0; k < 2; ++k) \
        acc[ai][bj][m][n] = __builtin_amdgcn_mfma_f32_16x16x32_bf16(Bt[n][k], At[m][k], acc[ai][bj][m][n], 0, 0, 0); __builtin_amdgcn_s_setprio(0); } while (0)
#define PG8_WAIT_V(n) asm volatile("s_waitcnt vmcnt(" #n ")" ::: "memory")
#define PG8_WAIT_L(n) asm volatile("s_waitcnt lgkmcnt(" #n ")" ::: "memory")
#define PG8_BAR __builtin_amdgcn_s_barrier()
#define PG8_SCHED __builtin_amdgcn_sched_barrier(0)
    Unit cur, nxt; int ui = 0;
    if (!S.next(0, cur)) return;
    f32x4 acc[2][2][4][2];
#pragma unroll
    for (int a = 0; a < 2; ++a)
#pragma unroll
        for (int b = 0; b < 2; ++b)
#pragma unroll
            for (int m = 0; m < 4; ++m)
#pragma unroll
                for (int n = 0; n < 2; ++n) acc[a][b][m][n] = (f32x4){0.f, 0.f, 0.f, 0.f};
    bf16x8 At[4][2], B0[2][2], B1[2][2];
    const char* cA = (const char*)g.A + (GATHER ? (size_t)0 : (size_t)cur.pm * tstep); const char* cB = (const char*)g.Bt + (size_t)cur.pn * tstep;
    S.a_ready(cur);
    if constexpr (GATHER) { PG8_ROWS(cur, cvo); __builtin_amdgcn_sched_barrier(0); }
    PG8_STAGE(PG8_SB(0, 0), cB, voffB); PG8_STAGE(PG8_SA(0, 0), cA, cvo[0]); PG8_STAGE(PG8_SB(0, 1), cB + hstep, voffB); PG8_STAGE(PG8_SA(0, 1), cA + hstepA, cvo[1]);
    if (wr == 1) PG8_BAR;
    PG8_WAIT_V(4); PG8_BAR;
    PG8_STAGE(PG8_SB(1, 0), cB + kstep, voffB); PG8_STAGE(PG8_SA(1, 0), cA + kstep, cvo[0]); PG8_STAGE(PG8_SB(1, 1), cB + hstep + kstep, voffB);
    PG8_WAIT_V(6); PG8_BAR;
    PG8_STAMP();
    for (;;) {
        const bool has_next = S.next(ui + 1, nxt);
        const char* nA = has_next ? (const char*)g.A + (GATHER ? (size_t)0 : (size_t)nxt.pm * tstep) : cA; const char* nB = has_next ? (const char*)g.Bt + (size_t)nxt.pn * tstep : cB;
        for (int t = 0; t < nt; t += 2) {
            const bool last = (t == nt - 2);
            const char* a1 = cA + (size_t)(t + 1) * kstep;
            const char* a2 = last ? nA : cA + (size_t)(t + 2) * kstep; const char* b2 = last ? nB : cB + (size_t)(t + 2) * kstep;
            const char* a3 = a2 + kstep; const char* b3 = b2 + kstep;
            if (last && has_next) { S.a_ready(nxt); if constexpr (GATHER) PG8_ROWS(nxt, nvo); }
            const bool usen = last && has_next;
#define PG8_VO2(hh_) (usen ? nvo[hh_] : cvo[hh_])
            PG8_LDB(B0, 0, 0); PG8_SCHED; PG8_LDA(At, 0, 0); PG8_STAGE(PG8_SA(1, 1), a1 + hstepA, cvo[1]);
            PG8_WAIT_L(8); PG8_BAR; PG8_WAIT_L(0); PG8_MMA(0, 0, At, B0); PG8_BAR; PG8_SCHED;
            PG8_LDB(B1, 0, 1); PG8_STAGE(PG8_SB(0, 0), b2, voffB);
            PG8_BAR; PG8_WAIT_L(0); PG8_MMA(0, 1, At, B1); PG8_BAR;
            PG8_LDA(At, 0, 1); PG8_STAGE(PG8_SA(0, 0), a2, PG8_VO2(0));
            PG8_BAR; PG8_WAIT_L(0); PG8_MMA(1, 0, At, B0); PG8_BAR; PG8_SCHED;
            PG8_STAGE(PG8_SB(0, 1), b2 + hstep, voffB);
            PG8_WAIT_V(6); PG8_BAR; PG8_MMA(1, 1, At, B1); PG8_BAR;
            PG8_LDB(B0, 1, 0); PG8_SCHED; PG8_LDA(At, 1, 0); PG8_STAGE(PG8_SA(0, 1), a2 + hstepA, PG8_VO2(1));
            PG8_WAIT_L(8); PG8_BAR; PG8_WAIT_L(0); PG8_MMA(0, 0, At, B0); PG8_BAR; PG8_SCHED;
            PG8_LDB(B1, 1, 1); PG8_STAGE(PG8_SB(1, 0), b3, voffB);
            PG8_BAR; PG8_WAIT_L(0); PG8_MMA(0, 1, At, B1); PG8_BAR;
            PG8_LDA(At, 1, 1); PG8_STAGE(PG8_SA(1, 0), a3, PG8_VO2(0));
            PG8_BAR; PG8_WAIT_L(0); PG8_MMA(1, 0, At, B0); PG8_BAR; PG8_SCHED;
            PG8_STAGE(PG8_SB(1, 1), b3 + hstep, voffB);
            PG8_WAIT_V(6); PG8_BAR; PG8_MMA(1, 1, At, B1); PG8_BAR;
        }
        PG8_STAMP();
        if constexpr (!Epi::AFTER_DRAIN) { int le_; asm volatile("v_mbcnt_lo_u32_b32 %0, -1, 0\n\tv_mbcnt_hi_u32_b32 %0, -1, %0" : "=&v"(le_)); E(acc, cur, wr, wc, le_ & 15, le_ >> 4); S.done(cur); }
        PG8_STAMP();
        if (!has_next) break;
#pragma unroll
        for (int a = 0; a < 2; ++a)
#pragma unroll
            for (int b = 0; b < 2; ++b)
#pragma unroll
                for (int m = 0; m < 4; ++m)
#pragma unroll
                    for (int n = 0; n < 2; ++n) acc[a][b][m][n] = (f32x4){0.f, 0.f, 0.f, 0.f};
        cur = nxt; cA = nA; cB = nB; ++ui;
        if constexpr (GATHER) {
#pragma unroll
            for (int hh_ = 0; hh_ < 2; ++hh_)
#pragma unroll
                for (int i = 0; i < 2; ++i) cvo[hh_][i] = nvo[hh_][i]; }
    }
    PG8_WAIT_V(0);
    if (wr == 0) PG8_BAR;
    PG8_BAR;
    if constexpr (Epi::AFTER_DRAIN) { E.fused(acc, cur, wr, wc, fr, fq, lds, wid, lane); S.done(cur); }
    PG8_STAMP();
    if (STAMP && wid == 0) { stamps[lane] = lane < nts ? (((unsigned long long)(unsigned)ts_hi << 32) | (unsigned)ts_lo) : 0ull;
        if (lane == 62) stamps[62] = rt_entry; if (lane == 63) stamps[63] = (unsigned long long)wall_clock64(); }
#undef PG8_STAMP
#undef PG8_SA
#undef PG8_SB
#undef PG8_STAGE
#undef PG8_ROWS
#undef PG8_VO2
#undef PG8_LDA
#undef PG8_LDB
#undef PG8_MMA
#undef PG8_WAIT_V
#undef PG8_WAIT_L
#undef PG8_BAR
#undef PG8_SCHED
}
}

constexpr int T = 16384, D = 2048, DEPTH = 4;
constexpr int NE = 6400, NO = 4352;
constexpr float ALPHA = 1.6817928305074292f;
constexpr float LN_EPS = 1e-5f, HN_EPS = 1e-6f;
constexpr int NWAVES = 8, NTHR = 512;
constexpr int XROWS = 2 * T + 4096;

constexpr int EC_MQ = 0, EC_MK = 512, EC_MV = 1024, EC_MO = 2048, EC_GQ = 3072, EC_GK = 3584, EC_GV = 4096, EC_GR = 5120;
constexpr int OC_Q = 0, OC_K = 2048, OC_V = 2560, OC_QI = 3072;

constexpr size_t MiB = 1u << 20;
constexpr size_t WS_CTL = 0, CTL_ZERO_BYTES = 1 * MiB;
constexpr size_t WS_WINE = 2 * MiB, WS_WINO = 52 * MiB, WS_WOUT = 86 * MiB, WS_WGU = 118 * MiB, WS_WDN = 374 * MiB;
constexpr size_t WS_HB = 502 * MiB, WS_SEL = 566 * MiB, WS_ROPE = 574 * MiB, WS_KI = 576 * MiB, WS_TOK = 578 * MiB, WS_LIST = 579 * MiB, WS_GLIST = 580 * MiB, WS_GS = 581 * MiB;
constexpr size_t WS_MST = 582 * MiB, WS_MPREV = WS_MST + 64 * 1024, WS_NST = 583 * MiB, WS_LAL = 584 * MiB;
constexpr size_t WS_R = 586 * MiB;
constexpr size_t WS_PROJ = WS_R, WS_SMALL = WS_R + 200 * MiB, WS_MIXO = WS_R + 208 * MiB, WS_MIX = WS_R + 272 * MiB, WS_STATES = WS_R + 336 * MiB, WS_QKC = WS_R + 464 * MiB, WS_LA = WS_R + 496 * MiB;
constexpr size_t WS_XG = WS_R, WS_HMID = WS_R + 144 * MiB, WS_Y = WS_R + 180 * MiB;
constexpr size_t WS_END = WS_R + 528 * MiB;
static_assert(WS_Y + (size_t)XROWS * D * 2 <= WS_END && WS_HMID + (size_t)XROWS * 512 * 2 <= WS_Y && WS_XG + (size_t)XROWS * D * 2 <= WS_HMID, "moe overlay");
constexpr int CW_BAR = 4096, CW_CNT = 8192;

constexpr int RING_BYTES = 131072, LDSCTL_OFF = RING_BYTES, LDS_BYTES = 163840;

#define LAS __attribute__((address_space(3)))
#define GAS __attribute__((address_space(1)))
typedef unsigned short bf16;
typedef unsigned v4u __attribute__((ext_vector_type(4)));
typedef unsigned v2u __attribute__((ext_vector_type(2)));
typedef float f32x4 __attribute__((ext_vector_type(4)));
typedef float f2v __attribute__((ext_vector_type(2)));
typedef int i4v __attribute__((ext_vector_type(4)));
typedef float f32x16 __attribute__((ext_vector_type(16)));
typedef short bf16x8 __attribute__((ext_vector_type(8)));
#define LDS_WAIT() asm volatile("s_waitcnt lgkmcnt(0)" ::: "memory")
__device__ __forceinline__ float bf2f(unsigned b) { return __uint_as_float(b << 16); }
typedef __bf16 bf2_t __attribute__((ext_vector_type(2)));
__device__ __forceinline__ unsigned f2bf(float f) { return (unsigned)__builtin_bit_cast(unsigned short, (__bf16)f); }
__device__ __forceinline__ unsigned pk2(float lo, float hi) { bf2_t v; v[0] = (__bf16)lo; v[1] = (__bf16)hi; return __builtin_bit_cast(unsigned, v); }
__device__ __forceinline__ float lo16(unsigned w) { return __uint_as_float(w << 16); }
__device__ __forceinline__ float hi16(unsigned w) { return __uint_as_float(w & 0xffff0000u); }
__device__ __forceinline__ float sigmoidf_(float x) { return __builtin_amdgcn_rcpf(1.0f + __expf(-x)); }
__device__ __forceinline__ float logsigmoidf_(float x) { return fminf(x, 0.0f) - __logf(1.0f + __expf(-fabsf(x))); }
__device__ __forceinline__ float wave_sum(float v) {
#pragma unroll
    for (int o = 1; o < 64; o <<= 1) v += __shfl_xor(v, o);
    return v;
}
__device__ __forceinline__ float wave_max(float v) {
#pragma unroll
    for (int o = 1; o < 64; o <<= 1) v = fmaxf(v, __shfl_xor(v, o));
    return v;
}

#define XB_TMO      128
#define XB_XCNT(j)  (256  + 64 * (j))
#define XB_XSUB(j)  (1280 + 64 * (j))
#define XB_XGEN(j)  (2304 + 64 * (j))
#define XB_TOP      3328
#define XB_TOPGEN   3392
#define XCD_BAR_WORDS 3456
#define XB_SPIN_CAP (1u << 24)
__device__ __forceinline__ unsigned xb_ld(GAS unsigned* p)              { return __hip_atomic_load(p, __ATOMIC_RELAXED, __HIP_MEMORY_SCOPE_AGENT); }
__device__ __forceinline__ unsigned xb_add(GAS unsigned* p, unsigned v) { return __hip_atomic_fetch_add(p, v, __ATOMIC_RELAXED, __HIP_MEMORY_SCOPE_AGENT); }
__device__ __forceinline__ unsigned xb_xcc_id() { return (unsigned)__builtin_amdgcn_s_getreg((3 << 11) | 20) & 0xFu; }
#define XB_SPIN(cond, bar) do { unsigned _sp = 0; while (cond) { __builtin_amdgcn_s_sleep(1); \
    if ((++_sp & 255u) == 0u) { if (xb_ld(&(bar)[XB_TMO])) break; if (_sp > XB_SPIN_CAP) { xb_add(&(bar)[XB_TMO], 1u); break; } } } } while (0)
struct XcdBarrier { GAS unsigned* bar; unsigned x; volatile LAS unsigned* st; };
__device__ __forceinline__ XcdBarrier xcd_barrier_post(GAS unsigned* bar, volatile LAS unsigned* st, bool leader) {
    XcdBarrier b; b.bar = bar; b.x = xb_xcc_id(); b.st = st;
    if (leader) (void)xb_add(&bar[XB_XCNT(b.x)], 1u);
    return b;
}
__device__ __forceinline__ void xcd_barrier_complete(GAS unsigned* bar, unsigned x, unsigned& nloc, unsigned& nx) {
    const unsigned G = gridDim.x * gridDim.y * gridDim.z;
    unsigned sum, cnt, mine, sp = 0u;
    for (;;) {
        sum = 0u; cnt = 0u; mine = 0u;
#pragma unroll
        for (unsigned j = 0; j < 16; ++j) { const unsigned c = xb_ld(&bar[XB_XCNT(j)]); sum += c; cnt += (c > 0u) ? 1u : 0u; mine = (j == x) ? c : mine; }
        if (sum == G) break;
        __builtin_amdgcn_s_sleep(1);
        if ((++sp & 255u) == 0u) { if (xb_ld(&bar[XB_TMO])) break; if (sp > XB_SPIN_CAP) { xb_add(&bar[XB_TMO], 1u); break; } }
    }
    nloc = mine > 0u ? mine : 1u; nx = cnt > 0u ? cnt : 1u;
}
__device__ __forceinline__ void xcd_barrier(const XcdBarrier& b, bool leader) {
    asm volatile("s_waitcnt vmcnt(0)" ::: "memory");
    __syncthreads();
    if (leader) {
        GAS unsigned* bar = b.bar;
        __builtin_amdgcn_s_waitcnt(0);
        unsigned nloc = b.st[0], nx = b.st[1];
        if (nloc == 0u) { xcd_barrier_complete(bar, b.x, nloc, nx); b.st[0] = nloc; b.st[1] = nx; }
        const unsigned old = xb_add(&bar[XB_XSUB(b.x)], 1u);
        const unsigned gen = old / nloc;
        if (old + 1u == (gen + 1u) * nloc) {
            __builtin_amdgcn_fence(__ATOMIC_RELEASE, "agent");
            asm volatile("s_waitcnt vmcnt(0)" ::: "memory");
            const unsigned og = xb_add(&bar[XB_TOP], 1u);
            const unsigned tg = og / nx;
            if (og + 1u == (tg + 1u) * nx) xb_add(&bar[XB_TOPGEN], 1u);
            else XB_SPIN(xb_ld(&bar[XB_TOPGEN]) == tg, bar);
            __builtin_amdgcn_fence(__ATOMIC_ACQUIRE, "agent");
            xb_add(&bar[XB_XGEN(b.x)], 1u);
            asm volatile("s_waitcnt vmcnt(0)" ::: "memory");
        } else {
            XB_SPIN(xb_ld(&bar[XB_XGEN(b.x)]) == gen, bar);
            __builtin_amdgcn_fence(__ATOMIC_ACQUIRE, "agent");
            asm volatile("s_waitcnt vmcnt(0)" ::: "memory");
        }
    }
    __syncthreads();
}

struct Args {
    const float* x; const int* pos; const float* ab_w_in; const float* ab_conv_w; const float* ab_igate_b; const float* ab_fgate_b; const float* ab_gla_w2; const float* ab_gla_b;
    const float* ab_mnorm; const float* ab_gnorm; const float* ab_w_out; const float* c_w_in; const float* c_w_out; const float* router_w; const float* router_b;
    const float* moe_gate; const float* moe_up; const float* moe_down; const float* ln_mix_g; const float* ln_mix_b; const float* ln_ffn_g; const float* ln_ffn_b;
    float* out; unsigned char* ws; int ph_lo, ph_hi;
};
#define CONSTAS __attribute__((address_space(4)))
typedef const CONSTAS Args* ArgsP;
__device__ __forceinline__ ArgsP opaque_args() { unsigned long long v = (unsigned long long)__builtin_amdgcn_kernarg_segment_ptr(); asm volatile("" : "+s"(v)); return (ArgsP)v; }
struct Ctx { LAS unsigned char* lds; int tid, lane, wave; };
struct LW { LAS unsigned char* p; int w; };
__device__ __forceinline__ int lane_id() { int l_; asm volatile("v_mbcnt_lo_u32_b32 %0, -1, 0\n\tv_mbcnt_hi_u32_b32 %0, -1, %0" : "=&v"(l_)); return l_; }
__device__ __forceinline__ Ctx make_ctx(LW lds) { Ctx c; int l = lane_id(), w = lds.w; asm volatile("" : "+v"(l)); asm volatile("" : "+s"(w)); c.lds = lds.p; c.tid = w * 64 + l; c.lane = l; c.wave = w; return c; }
__device__ __forceinline__ GAS unsigned char* opaque_ws(const void* p) { unsigned long long v = (unsigned long long)p; asm volatile("" : "+s"(v)); return (GAS unsigned char*)v; }

__device__ __forceinline__ void xpose_item(const GAS float* W, int ldw, int c0, int k0, GAS bf16* dst, int Kd, LAS float* scr, int lane) {
#pragma unroll 8
    for (int i = 0; i < 32; ++i) { const int kk = 2 * i + (lane >> 5); scr[kk * 33 + (lane & 31)] = W[(size_t)(k0 + kk) * ldw + c0 + (lane & 31)]; }
    LDS_WAIT();
    const int c = lane & 7;
#pragma unroll
    for (int j = 0; j < 4; ++j) { const int n = (lane >> 3) + 8 * j; const LAS float* s = scr + (8 * c) * 33 + n;
        v4u o; o.x = pk2(s[0 * 33], s[1 * 33]); o.y = pk2(s[2 * 33], s[3 * 33]); o.z = pk2(s[4 * 33], s[5 * 33]); o.w = pk2(s[6 * 33], s[7 * 33]);
        *(GAS v4u*)(dst + (size_t)n * Kd + k0 + 8 * c) = o; }
    LDS_WAIT();
}
__device__ __forceinline__ void phase_prologue(ArgsP ap, LW lds_) {
    const CONSTAS Args& a = *ap; const Ctx c = make_ctx(lds_); GAS unsigned char* ws = opaque_ws(a.ws);
    GAS bf16* WINE = (GAS bf16*)(ws + WS_WINE); GAS bf16* WINO = (GAS bf16*)(ws + WS_WINO); GAS bf16* WOUT = (GAS bf16*)(ws + WS_WOUT); GAS bf16* WGU = (GAS bf16*)(ws + WS_WGU); GAS bf16* WDN = (GAS bf16*)(ws + WS_WDN);
    LAS float* scr = (LAS float*)(c.lds + c.wave * 16384);
    const int gw = blockIdx.x * NWAVES + c.wave, NGW = gridDim.x * NWAVES;
    constexpr int I0 = 65536, I1 = 32768, I2 = 8192, I3 = 2 * 6144, I4 = 2 * 4160, NIT = I0 + I1 + I2 + I3 + I4;
    for (int it = gw; it < NIT; it += NGW) {
        int r = it;
        if (r < I0) { const int nb = r & 3, kb = (r >> 2) & 31, pn = (r >> 7) & 3, which = (r >> 9) & 1, le = r >> 10;
            const GAS float* src = (which ? ((const GAS float*)a.moe_up) : ((const GAS float*)a.moe_gate)) + (size_t)le * 2048 * 512;
            xpose_item(src, 512, 128 * pn + 32 * nb, 64 * kb, WGU + ((size_t)le * 1024 + 256 * pn + 128 * which + 32 * nb) * 2048, 2048, scr, c.lane); continue; }
        r -= I0;
        if (r < I1) { const int nb = r & 63, kb = (r >> 6) & 7, le = r >> 9;
            xpose_item(((const GAS float*)a.moe_down) + (size_t)le * 512 * 2048, 2048, 32 * nb, 64 * kb, WDN + ((size_t)le * 2048 + 32 * nb) * 512, 512, scr, c.lane); continue; }
        r -= I1;
        if (r < I2) { const int nb = r & 63, kb = (r >> 6) & 31, mat = r >> 11;
            const GAS float* src = mat < 2 ? ((const GAS float*)a.ab_w_out) + (size_t)mat * 2048 * 2048 : ((const GAS float*)a.c_w_out) + (size_t)(mat - 2) * 2048 * 2048;
            xpose_item(src, 2048, 32 * nb, 64 * kb, WOUT + (size_t)mat * 2048 * 2048 + (size_t)(32 * nb) * 2048, 2048, scr, c.lane); continue; }
        r -= I2;
        if (r < I3) { const int j = r / 6144, q = r % 6144, cb = q % 192, kb = q / 192, d = 32 * cb, sc = d < 2048 ? d : (d < 5120 ? d + 8 : d + 24);
            xpose_item(((const GAS float*)a.ab_w_in) + (size_t)j * 2048 * 6168, 6168, sc, 64 * kb, WINE + (size_t)j * NE * 2048 + (size_t)d * 2048, 2048, scr, c.lane); continue; }
        r -= I3;
        { const int j = r / 4160, q = r % 4160, cb = q % 130, kb = q / 130, d = 32 * cb;
            xpose_item(((const GAS float*)a.c_w_in) + (size_t)j * 2048 * 4176, 4176, d, 64 * kb, WINO + (size_t)j * NO * 2048 + (size_t)d * 2048, 2048, scr, c.lane); }
    }
    const int gt = blockIdx.x * NTHR + c.tid, NT = gridDim.x * NTHR;
    for (int i = gt; i < 2 * 24 * 2048; i += NT) { const int j = i / (24 * 2048), q = i % (24 * 2048), r = q / 2048, k = q % 2048, sc = r < 8 ? 2048 + r : 5128 + (r - 8);
        WINE[(size_t)j * NE * 2048 + (size_t)(6144 + r) * 2048 + k] = (bf16)f2bf(((const GAS float*)a.ab_w_in)[(size_t)j * 2048 * 6168 + (size_t)k * 6168 + sc]); }
    for (int i = gt; i < 2 * 232 * 2048; i += NT) { const int j = i / (232 * 2048), q = i % (232 * 2048); WINE[(size_t)j * NE * 2048 + (size_t)6168 * 2048 + q] = 0; }
    for (int i = gt; i < 2 * 16 * 2048; i += NT) { const int j = i / (16 * 2048), q = i % (16 * 2048), r = q / 2048, k = q % 2048;
        WINO[(size_t)j * NO * 2048 + (size_t)(4160 + r) * 2048 + k] = (bf16)f2bf(((const GAS float*)a.c_w_in)[(size_t)j * 2048 * 4176 + (size_t)k * 4176 + 4160 + r]); }
    for (int i = gt; i < 2 * 176 * 2048; i += NT) { const int j = i / (176 * 2048), q = i % (176 * 2048); WINO[(size_t)j * NO * 2048 + (size_t)4176 * 2048 + q] = 0; }
    { const GAS f32x4* x4 = (const GAS f32x4*)((const GAS float*)a.x); GAS v4u* hb = (GAS v4u*)(ws + WS_HB);
      for (int i = gt; i < T * D / 8; i += NT) { const f32x4 p = x4[2 * i], q = x4[2 * i + 1]; v4u o; o.x = pk2(p[0], p[1]); o.y = pk2(p[2], p[3]); o.z = pk2(q[0], q[1]); o.w = pk2(q[2], q[3]); hb[i] = o; } }
    { GAS f2v* rope = (GAS f2v*)(ws + WS_ROPE);
      for (int i = gt; i < T * 16; i += NT) { const int t = i >> 4, f = i & 15; const float inv = 1.0f / powf(500000.0f, (float)f / 16.0f);
          const double ang = (double)((const GAS int*)a.pos)[t] * (double)inv; rope[i] = (f2v){(float)cos(ang), (float)sin(ang)}; } }
}

template <int MODE> __device__ __forceinline__ void phase_ln(ArgsP ap, LW lds_, int layer) {
    const CONSTAS Args& a = *ap; const Ctx c = make_ctx(lds_); GAS unsigned char* ws = opaque_ws(a.ws);
    GAS bf16* HB = (GAS bf16*)(ws + WS_HB); const GAS bf16* MIX = (const GAS bf16*)(ws + WS_MIX); const GAS unsigned char* Y = (const GAS unsigned char*)(ws + WS_Y);
    GAS unsigned* cnt = (GAS unsigned*)(ws + WS_CTL) + CW_CNT + 64 * layer;
    GAS i4v* tok = (GAS i4v*)(ws + WS_TOK); GAS int* list = (GAS int*)(ws + WS_LIST); GAS float* glist = (GAS float*)(ws + WS_GLIST);
    const GAS float* g = (MODE == 0 ? ((const GAS float*)a.ln_mix_g) : ((const GAS float*)a.ln_ffn_g)) + layer * D; const GAS float* b = (MODE == 0 ? ((const GAS float*)a.ln_mix_b) : ((const GAS float*)a.ln_ffn_b)) + layer * D;
    const int gw = blockIdx.x * NWAVES + c.wave, NGW = gridDim.x * NWAVES, lane = c.lane;
    int soff[16];
    if (MODE == 1) { int acc = 0;
#pragma unroll
        for (int e = 0; e < 16; ++e) { soff[e] = acc; const int ce = (int)__builtin_amdgcn_readfirstlane((int)cnt[e]); acc += (ce + 255) & ~255; } }
    LAS f32x4* LW = (LAS f32x4*)c.lds;
    if (MODE == 0) { for (int idx = c.tid; idx < 8192; idx += NTHR) { const int d = idx >> 2, q = idx & 3, j = d >> 9, l = (d >> 3) & 63, i = d & 7; LW[((j * 8 + i) * 4 + q) * 64 + l] = *(const GAS f32x4*)(((const GAS float*)a.router_w) + (size_t)d * 16 + 4 * q); }
        __syncthreads(); }
    LAS int* rinfo = (LAS int*)(c.lds + 131072); LAS unsigned* lcnt = (LAS unsigned*)(c.lds + 131072 + 2048); LAS unsigned* lbase = lcnt + 16;
    LAS f32x4* GB = (LAS f32x4*)(c.lds + 135168);
    for (int idx = c.tid; idx < 1024; idx += NTHR) { const int l_ = idx & 63, hf = (idx >> 6) & 1, j_ = (idx >> 7) & 3, wh = idx >> 9; GB[idx] = *(const GAS f32x4*)((wh ? b : g) + 512 * j_ + 8 * l_ + 4 * hf); }
    LAS float* RBL = (LAS float*)(c.lds + 151552); if (MODE == 0 && c.tid < 16) RBL[c.tid] = ((const GAS float*)a.router_b)[c.tid];
    __syncthreads();
    const int rows_per_wave = (T + NGW - 1) / NGW;
    for (int k0 = 0; k0 < rows_per_wave; k0 += 8) {
      if (MODE == 0) { __syncthreads(); if (c.tid < 16) lcnt[c.tid] = 0u; __syncthreads(); }
      v4u nh[4], n1[4], n2[4]; i4v tkn = (i4v){0, 0, 0, 0};
#define LN_ISSUE(trow, tkv) do { const int t_ = (trow); if (t_ < T) { const GAS bf16* r1_; const GAS bf16* r2_ = nullptr; \
          if (MODE == 0) r1_ = MIX + (size_t)t_ * D; \
          else { int p0_ = 0, p1_ = 0; _Pragma("unroll") for (int e_ = 0; e_ < 16; ++e_) { if ((tkv).x == e_) p0_ = soff[e_] + (tkv).y; if ((tkv).z == e_) p1_ = soff[e_] + (tkv).w; } \
              r1_ = (const GAS bf16*)(Y + (size_t)p0_ * D); r2_ = (const GAS bf16*)(Y + (size_t)p1_ * D); }        \
          _Pragma("unroll") for (int j_ = 0; j_ < 4; ++j_) { nh[j_] = *(const GAS v4u*)(HB + (size_t)t_ * D + 512 * j_ + 8 * lane); \
              if (MODE == 0) { n1[j_] = *(const GAS v4u*)(r1_ + 512 * j_ + 8 * lane); n2[j_] = (v4u){0u, 0u, 0u, 0u}; } \
              else { const v2u a_ = *(const GAS v2u*)((const GAS unsigned char*)r1_ + 512 * j_ + 8 * lane), b_ = *(const GAS v2u*)((const GAS unsigned char*)r2_ + 512 * j_ + 8 * lane); \
                     n1[j_] = (v4u){a_[0], a_[1], 0u, 0u}; n2[j_] = (v4u){b_[0], b_[1], 0u, 0u}; } } } } while (0)
      { const int tf = gw + k0 * NGW; if (MODE == 1 && tf < T) tkn = tok[tf]; LN_ISSUE(tf, tkn); if (MODE == 1 && tf + NGW < T) tkn = tok[tf + NGW]; }
      for (int kk = 0; kk < 8; ++kk) { const int t = gw + (k0 + kk) * NGW; if (t >= T) continue;
        float v[32];
#pragma unroll
        for (int j = 0; j < 4; ++j) {
            if (MODE == 0) {
#pragma unroll
                for (int i = 0; i < 4; ++i) { v[8 * j + 2 * i] = ALPHA * lo16(nh[j][i]) + lo16(n1[j][i]); v[8 * j + 2 * i + 1] = ALPHA * hi16(nh[j][i]) + hi16(n1[j][i]); }
            } else {
#pragma unroll
                for (int i2 = 0; i2 < 2; ++i2) { const f2v a0_ = __builtin_amdgcn_cvt_pk_f32_fp8((int)n1[j][i2], false), a1_ = __builtin_amdgcn_cvt_pk_f32_fp8((int)n1[j][i2], true);
                    const f2v b0_ = __builtin_amdgcn_cvt_pk_f32_fp8((int)n2[j][i2], false), b1_ = __builtin_amdgcn_cvt_pk_f32_fp8((int)n2[j][i2], true);
                    v[8 * j + 4 * i2] = ALPHA * lo16(nh[j][2 * i2]) + (a0_[0] + b0_[0]) * 0.25f; v[8 * j + 4 * i2 + 1] = ALPHA * hi16(nh[j][2 * i2]) + (a0_[1] + b0_[1]) * 0.25f;
                    v[8 * j + 4 * i2 + 2] = ALPHA * lo16(nh[j][2 * i2 + 1]) + (a1_[0] + b1_[0]) * 0.25f; v[8 * j + 4 * i2 + 3] = ALPHA * hi16(nh[j][2 * i2 + 1]) + (a1_[1] + b1_[1]) * 0.25f; }
            }
        }
        if (kk + 1 < 8) { LN_ISSUE(t + NGW, tkn); if (MODE == 1 && kk + 2 < 8 && t + 2 * NGW < T) tkn = tok[t + 2 * NGW]; }
        float s = 0.f;
#pragma unroll
        for (int i = 0; i < 32; ++i) s += v[i];
        const float mean = wave_sum(s) * (1.0f / D); float s2 = 0.f;
#pragma unroll
        for (int i = 0; i < 32; ++i) { v[i] -= mean; s2 += v[i] * v[i]; }
        const float rstd = 1.0f / sqrtf(wave_sum(s2) * (1.0f / D) + LN_EPS);
#pragma unroll
        for (int j = 0; j < 4; ++j) { const f32x4 g0 = GB[(j * 2) * 64 + lane], g1 = GB[(j * 2 + 1) * 64 + lane], b0 = GB[512 + (j * 2) * 64 + lane], b1 = GB[512 + (j * 2 + 1) * 64 + lane];
#pragma unroll
            for (int i = 0; i < 4; ++i) { v[8 * j + i] = v[8 * j + i] * rstd * g0[i] + b0[i]; v[8 * j + 4 + i] = v[8 * j + 4 + i] * rstd * g1[i] + b1[i]; } }
        if (MODE == 1 && layer == DEPTH - 1) {
#pragma unroll
            for (int j = 0; j < 4; ++j) { GAS float* o = ((GAS float*)a.out) + (size_t)t * D + 512 * j + 8 * lane; *(GAS f32x4*)o = (f32x4){v[8 * j], v[8 * j + 1], v[8 * j + 2], v[8 * j + 3]}; *(GAS f32x4*)(o + 4) = (f32x4){v[8 * j + 4], v[8 * j + 5], v[8 * j + 6], v[8 * j + 7]}; }
        } else {
#pragma unroll
            for (int j = 0; j < 4; ++j) { v4u o; o.x = pk2(v[8 * j], v[8 * j + 1]); o.y = pk2(v[8 * j + 2], v[8 * j + 3]); o.z = pk2(v[8 * j + 4], v[8 * j + 5]); o.w = pk2(v[8 * j + 6], v[8 * j + 7]);
                *(GAS v4u*)(HB + (size_t)t * D + 512 * j + 8 * lane) = o; }
        }
        if (MODE == 0) {
            float lg[16];
#pragma unroll
            for (int e = 0; e < 16; ++e) lg[e] = 0.f;
#pragma unroll
            for (int j = 0; j < 4; ++j)
#pragma unroll
                for (int i = 0; i < 8; ++i) { const float y = v[8 * j + i]; if ((i & 1) == 0) asm volatile("" ::: "memory");
#pragma unroll
                    for (int q = 0; q < 4; ++q) { const f32x4 w = LW[((j * 8 + i) * 4 + q) * 64 + lane]; lg[4 * q] += y * w[0]; lg[4 * q + 1] += y * w[1]; lg[4 * q + 2] += y * w[2]; lg[4 * q + 3] += y * w[3]; } }
            float aff[16], sel[16];
#pragma unroll
            for (int e = 0; e < 16; ++e) { aff[e] = sigmoidf_(wave_sum(lg[e])); sel[e] = aff[e] + RBL[e]; }
            int gbest = 0; float gsbest = -1e30f;
#pragma unroll
            for (int gi = 0; gi < 4; ++gi) { float m1 = -1e30f, m2 = -1e30f;
#pragma unroll
                for (int k = 0; k < 4; ++k) { const float x = sel[4 * gi + k]; if (x > m1) { m2 = m1; m1 = x; } else if (x > m2) m2 = x; }
                const float gs = m1 + m2; if (gs > gsbest) { gsbest = gs; gbest = gi; } }
            float s0 = -1e30f, s1 = -1e30f; int l0 = 0, l1 = 0; float a0 = 0.f, a1 = 0.f;
#pragma unroll
            for (int gi = 0; gi < 4; ++gi) if (gi == gbest) {
#pragma unroll
                for (int k = 0; k < 4; ++k) { const float x = sel[4 * gi + k]; if (x > s0) { s1 = s0; l1 = l0; a1 = a0; s0 = x; l0 = k; a0 = aff[4 * gi + k]; } else if (x > s1) { s1 = x; l1 = k; a1 = aff[4 * gi + k]; } } }
            const int e0 = 4 * gbest + l0, e1 = 4 * gbest + l1; const float inv = 1.0f / (a0 + a1);
            if (lane == 0) { const int l0s = (int)__hip_atomic_fetch_add(lcnt + e0, 1u, __ATOMIC_RELAXED, __HIP_MEMORY_SCOPE_WORKGROUP), l1s = (int)__hip_atomic_fetch_add(lcnt + e1, 1u, __ATOMIC_RELAXED, __HIP_MEMORY_SCOPE_WORKGROUP);
                LAS int* ri = rinfo + (c.wave * 8 + kk) * 8; ri[0] = e0; ri[1] = l0s; ri[2] = e1; ri[3] = l1s; ri[4] = (int)__float_as_uint(a0 * inv); ri[5] = (int)__float_as_uint(a1 * inv); }
        }
      }
      if (MODE == 0) {
          __syncthreads(); if (c.tid < 16) lbase[c.tid] = xb_add(&cnt[c.tid], lcnt[c.tid]); __syncthreads();
          if (c.tid < 64) { const int w = c.tid >> 3, kk = c.tid & 7, t = (int)(blockIdx.x * NWAVES + w) + (k0 + kk) * NGW;
              if (t < T) { const LAS int* ri = rinfo + c.tid * 8; const int e0 = ri[0], e1 = ri[2], s0 = (int)lbase[e0] + ri[1], s1 = (int)lbase[e1] + ri[3];
                  list[e0 * T + s0] = t; glist[e0 * T + s0] = __uint_as_float((unsigned)ri[4]); list[e1 * T + s1] = t; glist[e1 * T + s1] = __uint_as_float((unsigned)ri[5]); tok[t] = (i4v){e0, s0, e1, s1}; } } }
    }
}

__device__ __forceinline__ void phase_gather(ArgsP ap, LW lds_, int layer) {
    const CONSTAS Args& a = *ap; const Ctx c = make_ctx(lds_); GAS unsigned char* ws = opaque_ws(a.ws); const GAS bf16* HB = (const GAS bf16*)(ws + WS_HB); GAS bf16* XG = (GAS bf16*)(ws + WS_XG); GAS float* GS = (GAS float*)(ws + WS_GS);
    const GAS unsigned* cnt = (const GAS unsigned*)(ws + WS_CTL) + CW_CNT + 64 * layer; const GAS int* list = (const GAS int*)(ws + WS_LIST); const GAS float* glist = (const GAS float*)(ws + WS_GLIST);
    int soff[17], cn[16]; { int acc = 0;
#pragma unroll
        for (int e = 0; e < 16; ++e) { soff[e] = acc; cn[e] = (int)__builtin_amdgcn_readfirstlane((int)cnt[e]); acc += (cn[e] + 255) & ~255; } soff[16] = acc; }
    const int gw = blockIdx.x * NWAVES + c.wave, NGW = gridDim.x * NWAVES, lane = c.lane;
    for (int p = gw; p < soff[16]; p += NGW) {
        int e = 0, so = 0, ce = 0;
#pragma unroll
        for (int k = 0; k < 16; ++k) if (soff[k] <= p) { e = k; so = soff[k]; ce = cn[k]; }
        const int s = p - so; GAS v4u* dst = (GAS v4u*)(XG + (size_t)p * D);
        if (s < ce) { const int tkn = list[e * T + s]; const GAS v4u* src = (const GAS v4u*)(HB + (size_t)tkn * D);
#pragma unroll
            for (int j = 0; j < 4; ++j) dst[64 * j + lane] = src[64 * j + lane];
            if (lane == 0) GS[p] = glist[e * T + s]; }
        else {
#pragma unroll
            for (int j = 0; j < 4; ++j) dst[64 * j + lane] = (v4u){0u, 0u, 0u, 0u};
            if (lane == 0) GS[p] = 0.f; }
    }
}

#define MFMA32(a, b, c) __builtin_amdgcn_mfma_f32_32x32x16_bf16((a), (b), (c), 0, 0, 0)
__device__ __forceinline__ bf16x8 frag_v(const LAS bf16* p) { return *(const LAS bf16x8*)p; }
__device__ __forceinline__ bf16x8 frag_s(const LAS bf16* p, int stride) { bf16x8 r;
#pragma unroll
    for (int j = 0; j < 8; ++j) r[j] = (short)p[j * stride];
    return r; }
typedef short s16x4 __attribute__((ext_vector_type(4)));
__device__ __forceinline__ bf16x8 frag_tr(const LAS bf16* base, int pitch, int k0, int rc0, int lane) {
    const int g = lane >> 4, i16 = lane & 15; const LAS bf16* a0 = base + (k0 + 8 * (g >> 1) + (i16 >> 2)) * pitch + rc0 + 16 * (g & 1) + 4 * (i16 & 3);
    const s16x4 r0 = __builtin_amdgcn_ds_read_tr16_b64_v4i16((LAS s16x4*)a0), r1 = __builtin_amdgcn_ds_read_tr16_b64_v4i16((LAS s16x4*)(a0 + 4 * pitch));
    return __builtin_shufflevector(r0, r1, 0, 1, 2, 3, 4, 5, 6, 7); }
__device__ __forceinline__ int drow(int reg, int h) { return (reg & 3) + 8 * (reg >> 2) + 4 * h; }
__device__ __forceinline__ f32x16 zero16() { f32x16 z;
#pragma unroll
    for (int i = 0; i < 16; ++i) z[i] = 0.f;
    return z; }

constexpr int LQ = 136, LV = 264, LP = 72, LKW = 144, LVV = 272;
constexpr float RSQ_DK = 0.08838834764831845f;
__device__ __forceinline__ void phase_chunk_a(ArgsP ap, LW lds_, int jl) {
    const CONSTAS Args& a = *ap; const Ctx c = make_ctx(lds_); GAS unsigned char* ws = opaque_ws(a.ws); const GAS bf16* PROJ = (const GAS bf16*)(ws + WS_PROJ); const GAS float* SMALL = (const GAS float*)(ws + WS_SMALL);
    GAS bf16* ST = (GAS bf16*)(ws + WS_STATES); GAS bf16* QKC = (GAS bf16*)(ws + WS_QKC); GAS float* LA = (GAS float*)(ws + WS_LA);
    GAS float* MST = (GAS float*)(ws + WS_MST); GAS float* NST = (GAS float*)(ws + WS_NST); GAS float* LAL = (GAS float*)(ws + WS_LAL);
    LAS bf16* kw = (LAS bf16*)(c.lds); LAS bf16* vv = (LAS bf16*)(c.lds + 18432); LAS float* wkv = (LAS float*)(c.lds + 53248); LAS float* laf = (LAS float*)(c.lds + 53504);
    const int tid = c.tid, lane = c.lane, wave = c.wave, r = lane & 31, h = lane >> 5;
    for (int u = blockIdx.x; u < 2048; u += gridDim.x) {
        const int n = u >> 3, hh = (u + (u >> 8)) & 7, t0 = n * 64;
        __syncthreads();
        if (hh < 4) {
            if (wave == 0) {
                const GAS float* sm = SMALL + (size_t)(t0 + lane) * 128;
                const float ig = sm[hh] + ((const GAS float*)a.ab_igate_b)[jl * 4 + hh]; const float lf = logsigmoidf_(sm[4 + hh] + ((const GAS float*)a.ab_fgate_b)[jl * 4 + hh]);
                float b = lf;
#pragma unroll
                for (int o = 1; o < 64; o <<= 1) { const float y = __shfl_up(b, o); if (lane >= o) b += y; }
                const float blast = __shfl(b, 63); const float av = blast - b + ig; const float ml = wave_max(av);
                wkv[lane] = __expf(av - ml);
                if (lane == 0) { MST[(n * 4 + hh) * 2] = blast; MST[(n * 4 + hh) * 2 + 1] = ml; }
            }
            __syncthreads();
            for (int it = tid; it < 2048; it += NTHR) {
                const int which = it >> 10, jj = (it >> 4) & 63, c8 = it & 15, t = t0 + jj;
                const int col = (which ? EC_MK : EC_MQ) + hh * 128 + 8 * c8, cch = which * 512 + hh * 128 + 8 * c8;
                float acc[8];
#pragma unroll
                for (int i = 0; i < 8; ++i) acc[i] = 0.f;
#pragma unroll
                for (int w = 0; w < 4; ++w) { const int tt = t - 3 + w; if (tt >= 0) {
                    const v4u xv = *(const GAS v4u*)(PROJ + (size_t)tt * NE + col); const GAS float* cw = ((const GAS float*)a.ab_conv_w) + (size_t)(jl * 4 + w) * 1024 + cch; const f32x4 c0 = *(const GAS f32x4*)cw, c1 = *(const GAS f32x4*)(cw + 4);
                    acc[0] += lo16(xv[0]) * c0[0]; acc[1] += hi16(xv[0]) * c0[1]; acc[2] += lo16(xv[1]) * c0[2]; acc[3] += hi16(xv[1]) * c0[3];
                    acc[4] += lo16(xv[2]) * c1[0]; acc[5] += hi16(xv[2]) * c1[1]; acc[6] += lo16(xv[3]) * c1[2]; acc[7] += hi16(xv[3]) * c1[3]; } }
#pragma unroll
                for (int i = 0; i < 8; ++i) acc[i] = acc[i] * sigmoidf_(acc[i]);
                if (which == 0) { v4u o; o.x = pk2(acc[0], acc[1]); o.y = pk2(acc[2], acc[3]); o.z = pk2(acc[4], acc[5]); o.w = pk2(acc[6], acc[7]);
                    *(GAS v4u*)(QKC + (size_t)t * 1024 + hh * 128 + 8 * c8) = o; }
                else {
#pragma unroll
                    for (int i = 0; i < 8; ++i) acc[i] *= RSQ_DK;
                    v4u o; o.x = pk2(acc[0], acc[1]); o.y = pk2(acc[2], acc[3]); o.z = pk2(acc[4], acc[5]); o.w = pk2(acc[6], acc[7]);
                    *(GAS v4u*)(QKC + (size_t)t * 1024 + 512 + hh * 128 + 8 * c8) = o;
                    const float wj = wkv[jj]; v4u p; p.x = pk2(acc[0] * wj, acc[1] * wj); p.y = pk2(acc[2] * wj, acc[3] * wj); p.z = pk2(acc[4] * wj, acc[5] * wj); p.w = pk2(acc[6] * wj, acc[7] * wj);
                    *(LAS v4u*)(kw + jj * LKW + 8 * c8) = p; }
            }
        } else {
            const int g = hh - 4;
            { const int d = tid & 127, jq = tid >> 7; float w2r[16];
#pragma unroll
              for (int q = 0; q < 16; ++q) w2r[q] = ((const GAS float*)a.ab_gla_w2)[(size_t)(jl * 16 + q) * 512 + g * 128 + d];
              const float gb = ((const GAS float*)a.ab_gla_b)[jl * 512 + g * 128 + d];
              for (int jj = jq * 16; jj < jq * 16 + 16; ++jj) { const GAS float* sm = SMALL + (size_t)(t0 + jj) * 128 + 8; float s = gb;
#pragma unroll
                  for (int q = 0; q < 16; ++q) s += sm[q] * w2r[q];
                  laf[jj * 128 + d] = logsigmoidf_(s) * (1.0f / 16.0f); } }
            __syncthreads();
            if (tid < 128) { float run = 0.f;
                for (int jj = 0; jj < 64; ++jj) { run += laf[jj * 128 + tid]; laf[jj * 128 + tid] = run; LA[(size_t)(t0 + jj) * 512 + g * 128 + tid] = run; }
                LAL[(n * 4 + g) * 128 + tid] = run; }
            __syncthreads();
            for (int it = tid; it < 1024; it += NTHR) { const int jj = it >> 4, c8 = it & 15;
                const v4u kv = *(const GAS v4u*)(PROJ + (size_t)(t0 + jj) * NE + EC_GK + g * 128 + 8 * c8); float kf[8];
#pragma unroll
                for (int i = 0; i < 4; ++i) { kf[2 * i] = lo16(kv[i]); kf[2 * i + 1] = hi16(kv[i]); }
#pragma unroll
                for (int i = 0; i < 8; ++i) kf[i] *= __expf(laf[63 * 128 + 8 * c8 + i] - laf[jj * 128 + 8 * c8 + i]);
                v4u p; p.x = pk2(kf[0], kf[1]); p.y = pk2(kf[2], kf[3]); p.z = pk2(kf[4], kf[5]); p.w = pk2(kf[6], kf[7]);
                *(LAS v4u*)(kw + jj * LKW + 8 * c8) = p; }
        }
        { const int vcol = hh < 4 ? EC_MV + hh * 256 : EC_GV + (hh - 4) * 256;
          for (int it = tid; it < 2048; it += NTHR) { const int jj = it >> 5, c8 = it & 31; *(LAS v4u*)(vv + jj * LVV + 8 * c8) = *(const GAS v4u*)(PROJ + (size_t)(t0 + jj) * NE + vcol + 8 * c8); } }
        __syncthreads();
        { const int db = wave & 3;
          for (int e4 = 0; e4 < 4; ++e4) { const int eb = (wave >> 2) * 4 + e4; f32x16 acc = zero16();
#pragma unroll
              for (int ks = 0; ks < 4; ++ks) { const bf16x8 A = frag_tr(kw, LKW, 16 * ks, 32 * db, lane), B = frag_tr(vv, LVV, 16 * ks, 32 * eb, lane); acc = MFMA32(A, B, acc); }
              GAS bf16* dst = ST + (size_t)(n * 8 + hh) * 32768 + 4 * h;
#pragma unroll
              for (int g4 = 0; g4 < 4; ++g4) { v2u w2; w2.x = pk2(acc[4 * g4], acc[4 * g4 + 1]); w2.y = pk2(acc[4 * g4 + 2], acc[4 * g4 + 3]);
                  *(GAS v2u*)(dst + (((eb * 8 + 2 * db + (g4 >> 1)) * 64 + 32 * (g4 & 1) + r) * 8)) = w2; } } }
        if (hh < 4 && tid < 128) { float s = 0.f; for (int jj = 0; jj < 64; ++jj) s += bf2f(kw[jj * LKW + tid]); NST[(n * 4 + hh) * 128 + tid] = s; }
    }
}
__device__ __forceinline__ void phase_scan(ArgsP ap, LW lds_) {
    const CONSTAS Args& a = *ap; const Ctx c = make_ctx(lds_); GAS unsigned char* ws = opaque_ws(a.ws); GAS unsigned* ST = (GAS unsigned*)(ws + WS_STATES);
    const GAS float* MST = (const GAS float*)(ws + WS_MST); GAS float* MPREV = (GAS float*)(ws + WS_MPREV); GAS float* NST = (GAS float*)(ws + WS_NST); const GAS float* LAL = (const GAS float*)(ws + WS_LAL);
    constexpr int NSTR = 8 * 256 * 64;
    for (int p0 = blockIdx.x * NTHR + c.tid; p0 < 8 * 256 * 64; p0 += gridDim.x * NTHR) {
        const int W_ = p0 >> 6, p = ((4 * ((W_ >> 2) & 1) + (W_ & 3)) << 14) + ((W_ >> 3) << 6) + (p0 & 63);
        const int hh = p >> 14, w = p & 16383, e = ((w >> 11) << 5) | ((w >> 2) & 31), dp = 8 * ((w >> 8) & 7) + 4 * ((w >> 7) & 1) + (w & 3);
        GAS unsigned* st = ST + (size_t)hh * 16384 + w;
        float c0 = 0.f, c1 = 0.f;
        if (hh < 4) {
            float m = 0.f, n0 = 0.f, n1 = 0.f; const bool nrm = e == 0;
            unsigned lda[16], ldb[16]; f2v gma[16], nla[16], gmb[16], nlb[16];
#define SC_LOADM(NB, LD, GM, NL) do { _Pragma("unroll") for (int k = 0; k < 16; ++k) LD[k] = st[(size_t)((NB) + k) * NSTR]; \
                _Pragma("unroll") for (int k = 0; k < 16; ++k) GM[k] = *(const GAS f2v*)(MST + (((NB) + k) * 4 + hh) * 2); \
                _Pragma("unroll") for (int k = 0; k < 16; ++k) NL[k] = *(const GAS f2v*)(NST + (((NB) + k) * 4 + hh) * 128 + 2 * dp);        \
                __builtin_amdgcn_sched_barrier(0); } while (0)
#define SC_RUNM(NB, LD, GM, NL) do { _Pragma("unroll") for (int k = 0; k < 16; ++k) { const int n = (NB) + k; const float g = GM[k].x, ml = GM[k].y; \
                    const float mn = fmaxf(g + m, ml), so = __expf(g + m - mn), sl = __expf(ml - mn); \
                    st[(size_t)n * NSTR] = pk2(c0, c1); c0 = so * c0 + sl * lo16(LD[k]); c1 = so * c1 + sl * hi16(LD[k]); \
                    if (nrm) { *(GAS f2v*)(NST + (n * 4 + hh) * 128 + 2 * dp) = (f2v){n0, n1}; n0 = so * n0 + sl * NL[k].x; n1 = so * n1 + sl * NL[k].y; \
                        if (dp == 0) MPREV[n * 4 + hh] = m; } \
                    m = mn; } __builtin_amdgcn_sched_barrier(0); } while (0)
            SC_LOADM(0, lda, gma, nla);
            for (int nb = 0; nb < 256; nb += 32) {
                SC_LOADM(nb + 16, ldb, gmb, nlb); SC_RUNM(nb, lda, gma, nla);
                if (nb + 32 < 256) SC_LOADM(nb + 32, lda, gma, nla);
                SC_RUNM(nb + 16, ldb, gmb, nlb); }
#undef SC_RUNM
#undef SC_LOADM
        } else {
            const int g = hh - 4;
            unsigned lda[16], ldb[16]; f2v dla[16], dlb[16];
#define SC_LOADG(NB, LD, DL) do { _Pragma("unroll") for (int k = 0; k < 16; ++k) LD[k] = st[(size_t)((NB) + k) * NSTR]; \
                _Pragma("unroll") for (int k = 0; k < 16; ++k) DL[k] = *(const GAS f2v*)(LAL + (((NB) + k) * 4 + g) * 128 + 2 * dp); \
                __builtin_amdgcn_sched_barrier(0); } while (0)
#define SC_RUNG(NB, LD, DL) do { _Pragma("unroll") for (int k = 0; k < 16; ++k) { const int n = (NB) + k; \
                    st[(size_t)n * NSTR] = pk2(c0, c1); c0 = __expf(DL[k].x) * c0 + lo16(LD[k]); c1 = __expf(DL[k].y) * c1 + hi16(LD[k]); } __builtin_amdgcn_sched_barrier(0); } while (0)
            SC_LOADG(0, lda, dla);
            for (int nb = 0; nb < 256; nb += 32) {
                SC_LOADG(nb + 16, ldb, dlb); SC_RUNG(nb, lda, dla);
                if (nb + 32 < 256) SC_LOADG(nb + 32, lda, dla);
                SC_RUNG(nb + 16, ldb, dlb); }
#undef SC_RUNG
#undef SC_LOADG
        }
    }
}
__device__ __forceinline__ void phase_chunk_c(ArgsP ap, LW lds_, int jl) {
    const CONSTAS Args& a = *ap; const Ctx c = make_ctx(lds_); GAS unsigned char* ws = opaque_ws(a.ws); const GAS bf16* PROJ = (const GAS bf16*)(ws + WS_PROJ); const GAS float* SMALL = (const GAS float*)(ws + WS_SMALL);
    const GAS bf16* ST = (const GAS bf16*)(ws + WS_STATES); const GAS bf16* QKC = (const GAS bf16*)(ws + WS_QKC); const GAS float* LA = (const GAS float*)(ws + WS_LA);
    const GAS float* MPREV = (const GAS float*)(ws + WS_MPREV); const GAS float* NST = (const GAS float*)(ws + WS_NST); GAS bf16* MIXO = (GAS bf16*)(ws + WS_MIXO);
    LAS bf16* qa = (LAS bf16*)(c.lds); LAS bf16* kb = (LAS bf16*)(c.lds + 17408); LAS bf16* vv = (LAS bf16*)(c.lds + 34816); LAS bf16* P = (LAS bf16*)(c.lds + 69632);
    LAS float* bvec = (LAS float*)(c.lds + 78848); LAS float* igv = bvec + 64; LAS float* mqv = bvec + 128; LAS float* sint = bvec + 192; LAS float* dn = bvec + 256; LAS float* rstd = bvec + 320;
    LAS float* rsq = bvec + 384; LAS float* nprev = bvec + 384 + 512; LAS bf16* qsm = (LAS bf16*)(c.lds + 82944); LAS bf16* ost = (LAS bf16*)(c.lds + 100352);
    const int tid = c.tid, lane = c.lane, wave = c.wave, r = lane & 31, h = lane >> 5;
    for (int u = blockIdx.x; u < 2048; u += gridDim.x) {
        const int n = u >> 3, hh = (u + (u >> 8)) & 7, t0 = n * 64, g = hh - 4;
        LAS bf16* qs = hh < 4 ? qsm : qa;
        __syncthreads();
        if (hh < 4 && wave == 0) {
            const GAS float* sm = SMALL + (size_t)(t0 + lane) * 128;
            const float ig = sm[hh] + ((const GAS float*)a.ab_igate_b)[jl * 4 + hh]; const float lf = logsigmoidf_(sm[4 + hh] + ((const GAS float*)a.ab_fgate_b)[jl * 4 + hh]);
            float b = lf;
#pragma unroll
            for (int o = 1; o < 64; o <<= 1) { const float y = __shfl_up(b, o); if (lane >= o) b += y; }
            float mx = ig - b;
#pragma unroll
            for (int o = 1; o < 64; o <<= 1) { const float y = __shfl_up(mx, o); if (lane >= o) mx = fmaxf(mx, y); }
            const float mp = MPREV[n * 4 + hh]; const float mq = b + fmaxf(mp, mx);
            bvec[lane] = b; igv[lane] = ig; mqv[lane] = mq; sint[lane] = __expf(b + mp - mq);
        }
        __syncthreads();
        if (hh < 4) {
            for (int it = tid; it < 2048; it += NTHR) { const int which = it >> 10, jj = (it >> 4) & 63, c8 = it & 15;
                const v4u x = *(const GAS v4u*)(QKC + (size_t)(t0 + jj) * 1024 + which * 512 + hh * 128 + 8 * c8);
                *(LAS v4u*)((which ? kb : qa) + jj * LQ + 8 * c8) = x;
                if (which == 0) { const float si = sint[jj]; v4u y;
#pragma unroll
                    for (int i = 0; i < 4; ++i) y[i] = pk2(lo16(x[i]) * si, hi16(x[i]) * si);
                    *(LAS v4u*)(qsm + jj * LQ + 8 * c8) = y; } }
            if (tid < 128) nprev[tid] = NST[(n * 4 + hh) * 128 + tid];
        } else {
            for (int it = tid; it < 1024; it += NTHR) { const int jj = it >> 4, c8 = it & 15; const size_t t = t0 + jj;
                const v4u qv = *(const GAS v4u*)(PROJ + t * NE + EC_GQ + g * 128 + 8 * c8), kv = *(const GAS v4u*)(PROJ + t * NE + EC_GK + g * 128 + 8 * c8);
                const f32x4 l0 = *(const GAS f32x4*)(LA + t * 512 + g * 128 + 8 * c8), l1 = *(const GAS f32x4*)(LA + t * 512 + g * 128 + 8 * c8 + 4);
                float qf[8], kf[8], el[8];
#pragma unroll
                for (int i = 0; i < 4; ++i) { qf[2 * i] = lo16(qv[i]); qf[2 * i + 1] = hi16(qv[i]); kf[2 * i] = lo16(kv[i]); kf[2 * i + 1] = hi16(kv[i]); el[i] = l0[i]; el[4 + i] = l1[i]; }
#pragma unroll
                for (int i = 0; i < 8; ++i) { qf[i] *= RSQ_DK * __expf(el[i]); kf[i] *= __expf(-el[i]); }
                v4u o; o.x = pk2(qf[0], qf[1]); o.y = pk2(qf[2], qf[3]); o.z = pk2(qf[4], qf[5]); o.w = pk2(qf[6], qf[7]); *(LAS v4u*)(qa + jj * LQ + 8 * c8) = o;
                v4u p; p.x = pk2(kf[0], kf[1]); p.y = pk2(kf[2], kf[3]); p.z = pk2(kf[4], kf[5]); p.w = pk2(kf[6], kf[7]); *(LAS v4u*)(kb + jj * LQ + 8 * c8) = p; }
        }
        { const int vcol = hh < 4 ? EC_MV + hh * 256 : EC_GV + g * 256;
          for (int it = tid; it < 2048; it += NTHR) { const int jj = it >> 5, c8 = it & 31; *(LAS v4u*)(vv + jj * LVV + 8 * c8) = *(const GAS v4u*)(PROJ + (size_t)(t0 + jj) * NE + vcol + 8 * c8); } }
        __syncthreads();
        if (wave < 4) { const int ib = wave >> 1, jb = wave & 1; f32x16 acc = zero16();
            if (jb <= ib) {
#pragma unroll
                for (int ks = 0; ks < 8; ++ks) { const bf16x8 A = frag_v(qa + (32 * ib + r) * LQ + 16 * ks + 8 * h), B = frag_v(kb + (32 * jb + r) * LQ + 16 * ks + 8 * h); acc = MFMA32(A, B, acc); } }
            const int jc = 32 * jb + r;
#pragma unroll
            for (int reg = 0; reg < 16; ++reg) { const int i = 32 * ib + drow(reg, h); float wv = 0.f;
                if (jc <= i) wv = hh < 4 ? acc[reg] * __expf(bvec[i] - bvec[jc] + igv[jc] - mqv[i]) : acc[reg];
                P[i * LP + jc] = (bf16)f2bf(wv); } }
        __syncthreads();
        if (hh < 4 && tid < 64) { const int i = tid; float s = 0.f; for (int jj = 0; jj < 64; ++jj) s += bf2f(P[i * LP + jj]);
            float qn = 0.f; for (int d = 0; d < 128; ++d) qn += bf2f(qa[i * LQ + d]) * nprev[d];
            dn[i] = fmaxf(fabsf(s + sint[i] * qn), __expf(-mqv[i])); }
        const int eb = wave;
#pragma unroll 1
        for (int ib = 0; ib < 2; ++ib) { f32x16 acc = zero16();
#pragma unroll
            for (int ks = 0; ks < 4; ++ks) { const bf16x8 B = frag_tr(vv, LVV, 16 * ks, 32 * eb, lane), A = frag_v(P + (32 * ib + r) * LP + 16 * ks + 8 * h); acc = MFMA32(A, B, acc); }
#pragma unroll
            for (int ks = 0; ks < 8; ++ks) { const bf16x8 B = *(const GAS bf16x8*)(ST + (size_t)(n * 8 + hh) * 32768 + ((eb * 8 + ks) * 64 + lane) * 8), A = frag_v(qs + (32 * ib + r) * LQ + 16 * ks + 8 * h); acc = MFMA32(A, B, acc); }
#pragma unroll
            for (int reg = 0; reg < 16; ++reg) { const int i = 32 * ib + drow(reg, h); const float o = acc[reg]; ost[i * LV + 32 * eb + r] = (bf16)f2bf(o); float sq = o * o;
#pragma unroll
                for (int of = 1; of < 32; of <<= 1) sq += __shfl_xor(sq, of);
                if (r == 0) rsq[i * 8 + wave] = sq; } }
        __syncthreads();
        if (tid < 64) { float s = 0.f;
#pragma unroll
            for (int w = 0; w < 8; ++w) s += rsq[tid * 8 + w];
            const float inv = hh < 4 ? 1.0f / dn[tid] : 1.0f;
            rstd[tid] = inv / sqrtf(s * inv * inv * (1.0f / 256.0f) + HN_EPS); }
        __syncthreads();
        { const GAS float* gainp = hh < 4 ? ((const GAS float*)a.ab_mnorm) + jl * 1024 + hh * 256 : ((const GAS float*)a.ab_gnorm) + jl * 1024 + g * 256;
          const int gcol = hh < 4 ? EC_MO + hh * 256 : EC_GR + g * 256, ocol = hh < 4 ? hh * 256 : 1024 + g * 256;
          for (int it = tid; it < 2048; it += NTHR) { const int i = it >> 5, c8 = it & 31; const size_t t = t0 + i;
              const v4u nv = *(const LAS v4u*)(ost + i * LV + 8 * c8), gv = *(const GAS v4u*)(PROJ + t * NE + gcol + 8 * c8);
              const f32x4 g0 = *(const GAS f32x4*)(gainp + 8 * c8), g1 = *(const GAS f32x4*)(gainp + 8 * c8 + 4); const float rs = rstd[i]; float o[8];
#pragma unroll
              for (int k = 0; k < 4; ++k) { const float x0 = lo16(gv[k]), x1 = hi16(gv[k]); const float t0g = hh < 4 ? sigmoidf_(x0) : x0 * sigmoidf_(x0), t1g = hh < 4 ? sigmoidf_(x1) : x1 * sigmoidf_(x1);
                  o[2 * k] = lo16(nv[k]) * rs * t0g; o[2 * k + 1] = hi16(nv[k]) * rs * t1g; }
              v4u w; w.x = pk2(o[0] * g0[0], o[1] * g0[1]); w.y = pk2(o[2] * g0[2], o[3] * g0[3]); w.z = pk2(o[4] * g1[0], o[5] * g1[1]); w.w = pk2(o[6] * g1[2], o[7] * g1[3]);
              *(GAS v4u*)(MIXO + t * D + ocol + 8 * c8) = w; } }
    }
}

constexpr size_t WS_K8 = WS_STATES, WS_V8 = WS_STATES + 8 * MiB;
__device__ __forceinline__ void rope8(float (&x)[8], const v4u raw, const f2v (&cs)[8], int pairbit, int dsel, int nrot) {
    v4u pr;
#pragma unroll
    for (int i = 0; i < 4; ++i) pr[i] = (unsigned)__shfl_xor((int)raw[i], pairbit);
    if (dsel < 2 * nrot) { const float sg = dsel < nrot ? -1.0f : 1.0f;
#pragma unroll
        for (int i = 0; i < 8; ++i) { const float y = (i & 1) ? hi16(pr[i >> 1]) : lo16(pr[i >> 1]); x[i] = x[i] * cs[i].x + sg * y * cs[i].y; } }
}
__device__ __forceinline__ void phase_rope(ArgsP ap, LW lds_) {
    const CONSTAS Args& a = *ap; const Ctx c = make_ctx(lds_); GAS unsigned char* ws = opaque_ws(a.ws); GAS bf16* PROJ = (GAS bf16*)(ws + WS_PROJ); const GAS float* SMALL = (const GAS float*)(ws + WS_SMALL); const GAS f2v* ROPE = (const GAS f2v*)(ws + WS_ROPE); GAS bf16* KI = (GAS bf16*)(ws + WS_KI);
    GAS unsigned char* K8 = ws + WS_K8; GAS unsigned char* V8 = ws + WS_V8;
    const int gw = blockIdx.x * NWAVES + c.wave, NGW = gridDim.x * NWAVES, lane = c.lane;
    const int dA = lane & 15, dB = lane & 7, d = lane; const bool actA = dA < 4, actB = dB < 2;
    v4u rawA[6], rawB[2]; f2v csA[8], csB[8]; float xk = 0.f, xp = 0.f; f2v csK = {1.f, 0.f};
    v4u nrawA[6], nrawB[2]; f2v ncsA[8], ncsB[8]; float nxk = 0.f, nxp = 0.f; f2v ncsK = {1.f, 0.f};
#define ROPE_LOADS(TT, RA, RB, CA, CB, XK, XP, CK) do { const GAS f2v* rp_ = ROPE + (size_t)(TT) * 16; const GAS bf16* pr_ = PROJ + (size_t)(TT) * NO; \
        _Pragma("unroll") for (int j = 0; j < 6; ++j) { const int col = (j < 4 ? OC_Q + 512 * j : (j == 4 ? OC_K : OC_V)) + 8 * lane; RA[j] = (v4u){0u, 0u, 0u, 0u}; if (j >= 4 || actA) RA[j] = *(const GAS v4u*)(pr_ + col); } \
        _Pragma("unroll") for (int j = 0; j < 2; ++j) { RB[j] = (v4u){0u, 0u, 0u, 0u}; if (actB) RB[j] = *(const GAS v4u*)(pr_ + OC_QI + 512 * j + 8 * lane); } \
        { const int f0 = 8 * (dA & 1);        \
          _Pragma("unroll") for (int i = 0; i < 8; ++i) { CA[i] = (f2v){1.f, 0.f}; if (actA) CA[i] = rp_[f0 + i]; CB[i] = (f2v){1.f, 0.f}; if (actB) CB[i] = rp_[2 * i]; } } \
        { const GAS float* sm_ = SMALL + (size_t)(TT) * 128; XK = sm_[d]; XP = 0.f; CK = (f2v){1.f, 0.f}; if (d < 16) { XP = sm_[d < 8 ? d + 8 : d - 8]; CK = rp_[2 * (d & 7)]; } } \
        __builtin_amdgcn_sched_barrier(0); } while (0)
    if (gw < T) ROPE_LOADS(gw, rawA, rawB, csA, csB, xk, xp, csK);
    for (int t = gw; t < T; t += NGW) {
        GAS bf16* pr = PROJ + (size_t)t * NO;
        if (t + NGW < T) ROPE_LOADS(t + NGW, nrawA, nrawB, ncsA, ncsB, nxk, nxp, ncsK);
        __builtin_amdgcn_sched_barrier(0);
        v4u outA[4], outB[2]; v2u out8[2];
#pragma unroll
        for (int j = 0; j < 6; ++j) { float x[8];
#pragma unroll
            for (int i = 0; i < 4; ++i) { x[2 * i] = lo16(rawA[j][i]); x[2 * i + 1] = hi16(rawA[j][i]); }
            if (j < 5) rope8(x, rawA[j], csA, 2, dA, 2);
            if (j < 4) { outA[j].x = pk2(x[0], x[1]); outA[j].y = pk2(x[2], x[3]); outA[j].z = pk2(x[4], x[5]); outA[j].w = pk2(x[6], x[7]); }
            else { int w0 = __builtin_amdgcn_cvt_pk_fp8_f32(x[0] * 16.f, x[1] * 16.f, 0, false); w0 = __builtin_amdgcn_cvt_pk_fp8_f32(x[2] * 16.f, x[3] * 16.f, w0, true);
                   int w1 = __builtin_amdgcn_cvt_pk_fp8_f32(x[4] * 16.f, x[5] * 16.f, 0, false); w1 = __builtin_amdgcn_cvt_pk_fp8_f32(x[6] * 16.f, x[7] * 16.f, w1, true);
                   out8[j - 4] = (v2u){(unsigned)w0, (unsigned)w1}; } }
#pragma unroll
        for (int j = 0; j < 2; ++j) { float x[8];
#pragma unroll
            for (int i = 0; i < 4; ++i) { x[2 * i] = lo16(rawB[j][i]); x[2 * i + 1] = hi16(rawB[j][i]); }
            rope8(x, rawB[j], csB, 1, dB, 1);
            outB[j].x = pk2(x[0], x[1]); outB[j].y = pk2(x[2], x[3]); outB[j].z = pk2(x[4], x[5]); outB[j].w = pk2(x[6], x[7]); }
        float ok = xk;
        if (d < 8) ok = xk * csK.x - xp * csK.y; else if (d < 16) ok = xk * csK.x + xp * csK.y;
#pragma unroll
        for (int j = 0; j < 4; ++j) if (actA) *(GAS v4u*)(pr + OC_Q + 512 * j + 8 * lane) = outA[j];
        *(GAS v2u*)(K8 + (size_t)t * 512 + 8 * lane) = out8[0]; *(GAS v2u*)(V8 + (size_t)t * 512 + 8 * lane) = out8[1];
#pragma unroll
        for (int j = 0; j < 2; ++j) if (actB) *(GAS v4u*)(pr + OC_QI + 512 * j + 8 * lane) = outB[j];
        KI[((size_t)((t >> 5) * 4 + (d >> 4)) * 64 + ((d >> 3) & 1) * 32 + (t & 31)) * 8 + (d & 7)] = (bf16)f2bf(ok);
#pragma unroll
        for (int j = 0; j < 6; ++j) rawA[j] = nrawA[j];
#pragma unroll
        for (int j = 0; j < 2; ++j) rawB[j] = nrawB[j];
#pragma unroll
        for (int i = 0; i < 8; ++i) { csA[i] = ncsA[i]; csB[i] = ncsB[i]; }
        xk = nxk; xp = nxp; csK = ncsK;
    }
#undef ROPE_LOADS
}
__device__ __forceinline__ unsigned short score_code(float s) { const _Float16 hv = (_Float16)s; const unsigned short hb = __builtin_bit_cast(unsigned short, hv); return (hb & 0x8000u) ? (unsigned short)~hb : (unsigned short)(hb | 0x8000u); }
__device__ __forceinline__ int wave_incl_scan_dpp(int v) {
    v += __builtin_amdgcn_update_dpp(0, v, 0x111, 0xf, 0xf, true);
    v += __builtin_amdgcn_update_dpp(0, v, 0x112, 0xf, 0xf, true);
    v += __builtin_amdgcn_update_dpp(0, v, 0x114, 0xf, 0xf, true);
    v += __builtin_amdgcn_update_dpp(0, v, 0x118, 0xf, 0xf, true);
    v += __builtin_amdgcn_update_dpp(0, v, 0x142, 0xa, 0xf, false);
    v += __builtin_amdgcn_update_dpp(0, v, 0x143, 0xc, 0xf, false);
    return v;
}
__device__ __forceinline__ void find_bin(const LAS unsigned* hA, const LAS unsigned* hB, int target, int lane, int& bin, int& above) {
    int h0 = (int)hA[4 * lane], h1 = (int)hA[4 * lane + 1], h2 = (int)hA[4 * lane + 2], h3 = (int)hA[4 * lane + 3];
    if (hB) { h0 += (int)hB[4 * lane]; h1 += (int)hB[4 * lane + 1]; h2 += (int)hB[4 * lane + 2]; h3 += (int)hB[4 * lane + 3]; }
    const int s = h0 + h1 + h2 + h3; const int incl = wave_incl_scan_dpp(s);
    const int suf = __builtin_amdgcn_readlane(incl, 63) - incl; const bool found = (suf < target) && (suf + s >= target);
    int b = 0, ab = 0; { int run = suf;
        if (run + h3 >= target) { b = 4 * lane + 3; ab = run; } else { run += h3;
        if (run + h2 >= target) { b = 4 * lane + 2; ab = run; } else { run += h2;
        if (run + h1 >= target) { b = 4 * lane + 1; ab = run; } else { run += h1; b = 4 * lane; ab = run; } } } }
    const unsigned long long m = __ballot(found); const int src = m ? (int)__builtin_ctzll(m) : 0;
    bin = __builtin_amdgcn_readlane(b, src); above = __builtin_amdgcn_readlane(ab, src);
}
__device__ __forceinline__ int wave_incl_scan(int v, int lane) {
#pragma unroll
    for (int o = 1; o < 64; o <<= 1) { const int y = __shfl_up(v, o); if (lane >= o) v += y; }
    return v;
}
__device__ __forceinline__ int mbcnt64(unsigned long long m, int add) { return (int)__builtin_amdgcn_mbcnt_hi((unsigned)(m >> 32), __builtin_amdgcn_mbcnt_lo((unsigned)m, (unsigned)add)); }
__device__ __forceinline__ void phase_index(ArgsP ap, LW lds_) {
    const CONSTAS Args& a = *ap; const Ctx c = make_ctx(lds_); GAS unsigned char* ws = opaque_ws(a.ws); const GAS bf16* PROJ = (const GAS bf16*)(ws + WS_PROJ); const GAS float* SMALL = (const GAS float*)(ws + WS_SMALL); const GAS bf16* KI = (const GAS bf16*)(ws + WS_KI); GAS unsigned short* SEL = (GAS unsigned short*)(ws + WS_SEL);
    LAS unsigned short* codes = (LAS unsigned short*)c.lds; LAS unsigned* hist1 = (LAS unsigned*)(c.lds + 131072); LAS unsigned* hist2 = (LAS unsigned*)(c.lds + 135168);
    const int tid = c.tid, lane = c.lane, wave = c.wave, r = lane & 31, h = lane >> 5;
    for (int rnd = 0; rnd * (int)gridDim.x < T / 4; ++rnd) {
        const int task = rnd * (int)gridDim.x + ((rnd & 1) ? (int)gridDim.x - 1 - (int)blockIdx.x : (int)blockIdx.x); if (task >= T / 4) continue;
        const int t0 = 4 * (T / 4 - 1 - task), nkt = (t0 + 4 + 31) >> 5;
        __syncthreads();
        for (int i = tid; i < 3073; i += NTHR) hist1[i] = 0u;
        bf16x8 A[2][4]; float wv[2][2][8];
#pragma unroll
        for (int rb = 0; rb < 2; ++rb) {
#pragma unroll
            for (int ks = 0; ks < 4; ++ks) A[rb][ks] = *(const GAS bf16x8*)(PROJ + (size_t)(t0 + 2 * rb + (r >> 4)) * NO + OC_QI + (r & 15) * 64 + 16 * ks + 8 * h);
#pragma unroll
            for (int qq = 0; qq < 2; ++qq) { const GAS float* wp = SMALL + (size_t)(t0 + 2 * rb + qq) * 128 + 64 + 4 * h; const f32x4 w0 = *(const GAS f32x4*)wp, w1 = *(const GAS f32x4*)(wp + 8);
#pragma unroll
                for (int k = 0; k < 4; ++k) { wv[rb][qq][k] = w0[k] * (1.0f / 64.0f); wv[rb][qq][4 + k] = w1[k] * (1.0f / 64.0f); } } }
        __syncthreads();
        const int nit = nkt > wave ? (nkt - wave + 7) >> 3 : 0;
        if (nit > 0) {
            bf16x8 Bqu[3][4];
#pragma unroll
            for (int sl = 0; sl < 3; ++sl) { int kt = wave + 8 * sl; kt = kt < nkt ? kt : nkt - 1;
#pragma unroll
                for (int ks = 0; ks < 4; ++ks) Bqu[sl][ks] = *(const GAS bf16x8*)(KI + ((size_t)(kt * 4 + ks) * 64 + lane) * 8); }
            for (int it0 = 0; it0 < nit; it0 += 3) {
#pragma unroll
                for (int sl = 0; sl < 3; ++sl) { const int it = it0 + sl, kt = wave + 8 * it;
                    if (it < nit) { const int key = 32 * kt + r; f32x16 acc0 = zero16(), acc1 = zero16();
#pragma unroll
                        for (int ks = 0; ks < 4; ++ks) { acc0 = MFMA32(A[0][ks], Bqu[sl][ks], acc0); acc1 = MFMA32(A[1][ks], Bqu[sl][ks], acc1); }
#pragma unroll
                        for (int rb = 0; rb < 2; ++rb) { float s0 = 0.f, s1 = 0.f;
#pragma unroll
                            for (int k8 = 0; k8 < 8; ++k8) { const float x0 = rb ? acc1[k8] : acc0[k8], x1 = rb ? acc1[8 + k8] : acc0[8 + k8];
                                s0 = fmaf(wv[rb][0][k8], x0, s0); s0 = fmaf(wv[rb][0][k8], fabsf(x0), s0); s1 = fmaf(wv[rb][1][k8], x1, s1); s1 = fmaf(wv[rb][1][k8], fabsf(x1), s1); }
                            const auto sw = __builtin_amdgcn_permlane32_swap(__float_as_uint(s0), __float_as_uint(s1), false, false);
                            const float sc = __uint_as_float(sw[0]) + __uint_as_float(sw[1]);
                            const int qq = 2 * rb + h; const bool valid = key <= t0 + qq; const unsigned cdv = valid ? (unsigned)score_code(sc) : 0u;
                            codes[qq * 16384 + key] = (unsigned short)cdv;
                            __hip_atomic_fetch_add(hist1 + (valid ? qq * 256 + (int)(cdv >> 8) : 3072), 1u, __ATOMIC_RELAXED, __HIP_MEMORY_SCOPE_WORKGROUP); } }
                    { int kn = kt + 24; kn = kn < nkt ? kn : nkt - 1;
#pragma unroll
                      for (int ks = 0; ks < 4; ++ks) Bqu[sl][ks] = *(const GAS bf16x8*)(KI + ((size_t)(kn * 4 + ks) * 64 + lane) * 8); } } } }
        __syncthreads();
        const int row = wave >> 1, half = wave & 1, t = t0 + row, nv = t + 1; const bool small = nv <= 256;
        const LAS unsigned short* cd = codes + row * 16384; GAS unsigned short* out = SEL + (size_t)t * 256;
        const int nvh = (((nv + 1) >> 1) + 511) & ~511; const int beg = half ? nvh : 0, end = half ? nv : (nvh < nv ? nvh : nv);
        int b1 = 0, ab1 = 0;
        if (!small) { find_bin(hist1 + row * 256, nullptr, 256, lane, b1, ab1);
            for (int base = beg + 8 * lane; base < end; base += 512) { const v4u c8 = *(const LAS v4u*)(cd + base);
                unsigned mm = 0u;
#pragma unroll
                for (int j = 0; j < 8; ++j) { const unsigned cv = (j & 1) ? (c8[j >> 1] >> 16) : (c8[j >> 1] & 0xffffu); mm |= (base + j < end && (int)(cv >> 8) == b1) ? (1u << j) : 0u; }
                while (mm) { const int j = __builtin_ctz(mm); mm &= mm - 1u;
                    const unsigned w_ = j < 4 ? (j < 2 ? c8[0] : c8[1]) : (j < 6 ? c8[2] : c8[3]); const unsigned cv = (j & 1) ? (w_ >> 16) : (w_ & 0xffffu);
                    __hip_atomic_fetch_add(hist2 + (row * 2 + half) * 256 + (cv & 255u), 1u, __ATOMIC_RELAXED, __HIP_MEMORY_SCOPE_WORKGROUP); } } }
        __syncthreads();
        if (small) { if (half == 0) for (int i = lane; i < nv; i += 64) out[i] = (unsigned short)i; }
        else {
            int b2, ab2; find_bin(hist2 + row * 512, hist2 + row * 512 + 256, 256 - ab1, lane, b2, ab2);
            const int eq0 = (int)hist2[row * 512 + b2], need_eq = 256 - ab1 - ab2; const int my_need = half ? (need_eq - eq0 > 0 ? need_eq - eq0 : 0) : (need_eq < eq0 ? need_eq : eq0);
            const unsigned thr = ((unsigned)b1 << 8) | (unsigned)b2; int run = 0, run_eq = 0;
            for (int base0 = beg; base0 < end; base0 += 512) { const int base = base0 + 8 * lane; v4u c8 = (v4u){0u, 0u, 0u, 0u}; if (base < end) c8 = *(const LAS v4u*)(cd + base);
                unsigned gtm = 0u, eqm = 0u;
#pragma unroll
                for (int j = 0; j < 8; ++j) { const unsigned cv = (j & 1) ? (c8[j >> 1] >> 16) : (c8[j >> 1] & 0xffffu); const bool ok = base + j < end;
                    gtm |= (ok && cv > thr) ? (1u << j) : 0u; eqm |= (ok && cv == thr) ? (1u << j) : 0u; }
                unsigned tm = gtm;
                if (__ballot(eqm != 0u)) {
                    int er = run_eq, tot = 0;
#pragma unroll
                    for (int j = 0; j < 8; ++j) { const unsigned long long bj = __ballot((eqm >> j) & 1u); er = mbcnt64(bj, er); tot += __popcll(bj); }
#pragma unroll
                    for (int j = 0; j < 8; ++j) if ((eqm >> j) & 1u) { if (er < my_need) tm |= (1u << j); ++er; }
                    run_eq += tot; }
                const int cnt = __popc(tm), incl = wave_incl_scan_dpp(cnt), tot = __builtin_amdgcn_readlane(incl, 63);
                int pos = run + incl - cnt;
                while (tm) { const int j = __builtin_ctz(tm); tm &= tm - 1u; const int pp = half ? 255 - pos : pos; if (pp >= 0 && pp < 256) out[pp] = (unsigned short)(base + j); ++pos; }
                run += tot; }
        }
    }
}
#define MFMA16(a, b, c) __builtin_amdgcn_mfma_f32_16x16x32_bf16((a), (b), (c), 0, 0, 0)
constexpr int CW_ACNT = 12288;
constexpr int LVA = 144;

__device__ __forceinline__ void attn_task(const GAS bf16* PROJ, const GAS unsigned char* K8, const GAS unsigned char* V8, const GAS unsigned short* SEL, GAS bf16* MIXO, LAS bf16* kt, LAS bf16* vt, LAS unsigned short* ksm, int t, int g, int lane) {
    const int c16 = lane & 15, q4 = lane >> 4, nk = t + 1 < 256 ? t + 1 : 256, nst = (nk + 31) >> 5;
    const GAS char* pb = (const GAS char*)PROJ;
#pragma unroll
    for (int i = 0; i < 4; ++i) { const int k = lane + 64 * i; ksm[k] = k < nk ? SEL[(size_t)t * 256 + k] : (unsigned short)0; }
    bf16x8 Bq[4];
#pragma unroll
    for (int ks = 0; ks < 4; ++ks) { bf16x8 z = {0, 0, 0, 0, 0, 0, 0, 0}; if (c16 < 4) z = *(const GAS bf16x8*)(pb + (unsigned)((t * NO + OC_Q + (4 * g + c16) * 128 + 32 * ks + 8 * q4) * 2)); Bq[ks] = z; }
    v4u rk[4], rv[4];
    const int r8 = lane >> 3, c8 = lane & 7; const unsigned coff = (unsigned)(g * 128 + 16 * c8);
#pragma unroll
    for (int i = 0; i < 4; ++i) { const unsigned ro = (unsigned)(ksm[r8 + 8 * i] * 512) + coff; rk[i] = *(const GAS v4u*)(K8 + ro); rv[i] = *(const GAS v4u*)(V8 + ro); }
    float m = -1e30f, ssum = 0.f; f32x4 o[8];
#pragma unroll
    for (int dt = 0; dt < 8; ++dt) o[dt] = (f32x4){0.f, 0.f, 0.f, 0.f};
    const LAS bf16* trp = vt + (4 * q4 + (c16 >> 2)) * LVA + 4 * (c16 & 3);
#pragma unroll 1
    for (int st = 0; st < nst; ++st) {
#pragma unroll
        for (int i = 0; i < 4; ++i) { v4u a0, a1, b0, b1;
#pragma unroll
            for (int w = 0; w < 2; ++w) {
                a0[2 * w] = __builtin_bit_cast(unsigned, __builtin_amdgcn_cvt_scalef32_pk_bf16_fp8(rk[i][w], 1.0f, false)); a0[2 * w + 1] = __builtin_bit_cast(unsigned, __builtin_amdgcn_cvt_scalef32_pk_bf16_fp8(rk[i][w], 1.0f, true));
                a1[2 * w] = __builtin_bit_cast(unsigned, __builtin_amdgcn_cvt_scalef32_pk_bf16_fp8(rk[i][2 + w], 1.0f, false)); a1[2 * w + 1] = __builtin_bit_cast(unsigned, __builtin_amdgcn_cvt_scalef32_pk_bf16_fp8(rk[i][2 + w], 1.0f, true));
                b0[2 * w] = __builtin_bit_cast(unsigned, __builtin_amdgcn_cvt_scalef32_pk_bf16_fp8(rv[i][w], 1.0f, false)); b0[2 * w + 1] = __builtin_bit_cast(unsigned, __builtin_amdgcn_cvt_scalef32_pk_bf16_fp8(rv[i][w], 1.0f, true));
                b1[2 * w] = __builtin_bit_cast(unsigned, __builtin_amdgcn_cvt_scalef32_pk_bf16_fp8(rv[i][2 + w], 1.0f, false)); b1[2 * w + 1] = __builtin_bit_cast(unsigned, __builtin_amdgcn_cvt_scalef32_pk_bf16_fp8(rv[i][2 + w], 1.0f, true)); }
            LAS bf16* kd = kt + (r8 + 8 * i) * LVA + 16 * c8; LAS bf16* vd = vt + (r8 + 8 * i) * LVA + 16 * c8;
            *(LAS v4u*)kd = a0; *(LAS v4u*)(kd + 8) = a1; *(LAS v4u*)vd = b0; *(LAS v4u*)(vd + 8) = b1; }
        { const int sn = st + 1 < nst ? st + 1 : st;
#pragma unroll
          for (int i = 0; i < 4; ++i) { const unsigned ro = (unsigned)(ksm[32 * sn + r8 + 8 * i] * 512) + coff; rk[i] = *(const GAS v4u*)(K8 + ro); rv[i] = *(const GAS v4u*)(V8 + ro); } }
        f32x4 l0 = {0.f, 0.f, 0.f, 0.f}, l1 = {0.f, 0.f, 0.f, 0.f};
#pragma unroll
        for (int ks = 0; ks < 4; ++ks) { const bf16x8 A0 = *(const LAS bf16x8*)(kt + c16 * LVA + 32 * ks + 8 * q4), A1 = *(const LAS bf16x8*)(kt + (16 + c16) * LVA + 32 * ks + 8 * q4);
            l0 = MFMA16(A0, Bq[ks], l0); l1 = MFMA16(A1, Bq[ks], l1); }
        float mx = -1e30f;
#pragma unroll
        for (int rg = 0; rg < 4; ++rg) { const int k0 = 32 * st + 4 * q4 + rg; l0[rg] = k0 < nk ? l0[rg] * (RSQ_DK * 0.0625f) : -1e30f; l1[rg] = k0 + 16 < nk ? l1[rg] * (RSQ_DK * 0.0625f) : -1e30f; mx = fmaxf(mx, fmaxf(l0[rg], l1[rg])); }
        mx = fmaxf(mx, __shfl_xor(mx, 16)); mx = fmaxf(mx, __shfl_xor(mx, 32));
        const float mn = fmaxf(m, mx), alpha = __expf(m - mn); m = mn;
        float e[8], ps = 0.f;
#pragma unroll
        for (int rg = 0; rg < 4; ++rg) { e[rg] = __expf(l0[rg] - mn); e[4 + rg] = __expf(l1[rg] - mn); ps += e[rg] + e[4 + rg]; }
        ssum = ssum * alpha + ps;
        v4u pw; pw.x = pk2(e[0], e[1]); pw.y = pk2(e[2], e[3]); pw.z = pk2(e[4], e[5]); pw.w = pk2(e[6], e[7]); const bf16x8 Ap = __builtin_bit_cast(bf16x8, pw);
        float al[4];
#pragma unroll
        for (int rg = 0; rg < 4; ++rg) al[rg] = __uint_as_float((unsigned)__builtin_amdgcn_readlane((int)__float_as_uint(alpha), rg));
#pragma unroll
        for (int dt = 0; dt < 8; ++dt) { const s16x4 r0 = __builtin_amdgcn_ds_read_tr16_b64_v4i16((LAS s16x4*)(trp + 16 * dt)), r1 = __builtin_amdgcn_ds_read_tr16_b64_v4i16((LAS s16x4*)(trp + 16 * LVA + 16 * dt));
            const bf16x8 Bv = __builtin_shufflevector(r0, r1, 0, 1, 2, 3, 4, 5, 6, 7);
            f32x4 oc = o[dt];
#pragma unroll
            for (int rg = 0; rg < 4; ++rg) oc[rg] *= al[rg];
            o[dt] = MFMA16(Ap, Bv, oc); }
    }
    ssum += __shfl_xor(ssum, 16); ssum += __shfl_xor(ssum, 32);
    float inv[4];
#pragma unroll
    for (int rg = 0; rg < 4; ++rg) inv[rg] = 0.0625f / __shfl(ssum, rg);
    LAS bf16* ob = kt;
    if (q4 == 0) {
#pragma unroll
        for (int rg = 0; rg < 4; ++rg)
#pragma unroll
            for (int dt = 0; dt < 8; ++dt) ob[rg * 128 + 16 * dt + c16] = (bf16)f2bf(o[dt][rg] * inv[rg]);
    }
    const v4u ov = *(const LAS v4u*)(ob + q4 * 128 + 8 * c16);
    *(GAS v4u*)(MIXO + (size_t)t * D + (4 * g + q4) * 128 + 8 * c16) = ov;
}
#define AT_CVT(dst, src) do { _Pragma("unroll") for (int w_ = 0; w_ < 2; ++w_) { \
    (dst##0)[2 * w_] = __builtin_bit_cast(unsigned, __builtin_amdgcn_cvt_scalef32_pk_bf16_fp8((src)[w_], 1.0f, false)); (dst##0)[2 * w_ + 1] = __builtin_bit_cast(unsigned, __builtin_amdgcn_cvt_scalef32_pk_bf16_fp8((src)[w_], 1.0f, true)); \
    (dst##1)[2 * w_] = __builtin_bit_cast(unsigned, __builtin_amdgcn_cvt_scalef32_pk_bf16_fp8((src)[2 + w_], 1.0f, false)); (dst##1)[2 * w_ + 1] = __builtin_bit_cast(unsigned, __builtin_amdgcn_cvt_scalef32_pk_bf16_fp8((src)[2 + w_], 1.0f, true)); } } while (0)
#define AT_WRITE(TB, R) do { _Pragma("unroll") for (int i_ = 0; i_ < 4; ++i_) { v4u a0, a1; AT_CVT(a, (R)[i_]); LAS bf16* d_ = (TB) + (r8 + 8 * i_) * LVA + 16 * c8; *(LAS v4u*)d_ = a0; *(LAS v4u*)(d_ + 8) = a1; } } while (0)
#define AT_WRITE_K8(TB, R) do { _Pragma("unroll") for (int i_ = 0; i_ < 4; ++i_) *(LAS v4u*)((LAS unsigned char*)(TB) + (r8 + 8 * i_) * 144 + 16 * c8) = (R)[i_]; } while (0)
#define AT_F8FRAG(dst, p) do { const v2u w_ = *(const LAS v2u*)(p); v4u t_; t_[0] = __builtin_bit_cast(unsigned, __builtin_amdgcn_cvt_scalef32_pk_bf16_fp8(w_[0], 1.0f, false)); t_[1] = __builtin_bit_cast(unsigned, __builtin_amdgcn_cvt_scalef32_pk_bf16_fp8(w_[0], 1.0f, true)); \
    t_[2] = __builtin_bit_cast(unsigned, __builtin_amdgcn_cvt_scalef32_pk_bf16_fp8(w_[1], 1.0f, false)); t_[3] = __builtin_bit_cast(unsigned, __builtin_amdgcn_cvt_scalef32_pk_bf16_fp8(w_[1], 1.0f, true)); (dst) = __builtin_bit_cast(bf16x8, t_); } while (0)
#define AT_QK8(TB, ST) do { f32x4 l0 = {0.f, 0.f, 0.f, 0.f}, l1 = {0.f, 0.f, 0.f, 0.f}; const LAS unsigned char* kb_ = (const LAS unsigned char*)(TB); \
    _Pragma("unroll") for (int ks = 0; ks < 4; ++ks) { const long A0 = *(const LAS long*)(kb_ + c16 * 144 + 32 * ks + 8 * q4), A1 = *(const LAS long*)(kb_ + (16 + c16) * 144 + 32 * ks + 8 * q4);        \
        l0 = __builtin_amdgcn_mfma_f32_16x16x32_fp8_fp8(A0, Bq[ks], l0, 0, 0, 0); l1 = __builtin_amdgcn_mfma_f32_16x16x32_fp8_fp8(A1, Bq[ks], l1, 0, 0, 0); } \
    lg[2 * (ST)] = l0; lg[2 * (ST) + 1] = l1; } while (0)
#define AT_Q8(dst, z) do { const v4u w_ = __builtin_bit_cast(v4u, (z)); \
    int a_ = __builtin_amdgcn_cvt_pk_fp8_f32(lo16(w_[0]) * 4.f, hi16(w_[0]) * 4.f, 0, false); a_ = __builtin_amdgcn_cvt_pk_fp8_f32(lo16(w_[1]) * 4.f, hi16(w_[1]) * 4.f, a_, true); \
    int b_ = __builtin_amdgcn_cvt_pk_fp8_f32(lo16(w_[2]) * 4.f, hi16(w_[2]) * 4.f, 0, false); b_ = __builtin_amdgcn_cvt_pk_fp8_f32(lo16(w_[3]) * 4.f, hi16(w_[3]) * 4.f, b_, true); \
    (dst) = (long)(((unsigned long long)(unsigned)b_ << 32) | (unsigned long long)(unsigned)a_); } while (0)
#define AT_LOAD(R, BASE, KS, STEP) do { _Pragma("unroll") for (int i_ = 0; i_ < 4; ++i_) { const unsigned ro_ = (unsigned)(KS)[32 * (STEP) + r8 + 8 * i_] * 512u + coff; (R)[i_] = *(const GAS v4u*)((BASE) + ro_); } \
    __builtin_amdgcn_sched_barrier(0); } while (0)
#define AT_QK(TB, ST) do { f32x4 l0 = {0.f, 0.f, 0.f, 0.f}, l1 = {0.f, 0.f, 0.f, 0.f}; \
    _Pragma("unroll") for (int ks = 0; ks < 4; ++ks) { const bf16x8 A0 = *(const LAS bf16x8*)((TB) + c16 * LVA + 32 * ks + 8 * q4), A1 = *(const LAS bf16x8*)((TB) + (16 + c16) * LVA + 32 * ks + 8 * q4); l0 = MFMA16(A0, Bq[ks], l0); l1 = MFMA16(A1, Bq[ks], l1); } \
    lg[2 * (ST)] = l0; lg[2 * (ST) + 1] = l1; } while (0)
#define AT_PV(TB, ST) do { const LAS bf16* trp_ = (TB) + (4 * q4 + (c16 >> 2)) * LVA + 4 * (c16 & 3); \
    _Pragma("unroll") for (int dt = 0; dt < 8; ++dt) { const s16x4 r0 = __builtin_amdgcn_ds_read_tr16_b64_v4i16((LAS s16x4*)(trp_ + 16 * dt)), r1 = __builtin_amdgcn_ds_read_tr16_b64_v4i16((LAS s16x4*)(trp_ + 16 * LVA + 16 * dt)); \
        const bf16x8 Bv = __builtin_shufflevector(r0, r1, 0, 1, 2, 3, 4, 5, 6, 7); o[dt] = MFMA16(Ap[ST], Bv, o[dt]); } } while (0)
#define AT_PV8(TB, ST) do { const LAS unsigned char* vb_ = (const LAS unsigned char*)(TB) + (4 * q4 + (c16 >> 2)) * 144 + 8 * (c16 & 3); \
    _Pragma("unroll") for (int dg = 0; dg < 4; ++dg) { const s16x4 r0 = __builtin_amdgcn_ds_read_tr16_b64_v4i16((LAS s16x4*)(vb_ + 32 * dg)), r1 = __builtin_amdgcn_ds_read_tr16_b64_v4i16((LAS s16x4*)(vb_ + 16 * 144 + 32 * dg)); \
        const v2u a_ = __builtin_bit_cast(v2u, r0), b_ = __builtin_bit_cast(v2u, r1); \
        const unsigned e0 = __builtin_amdgcn_perm(a_[1], a_[0], 0x06040200u), o0 = __builtin_amdgcn_perm(a_[1], a_[0], 0x07050301u), e1 = __builtin_amdgcn_perm(b_[1], b_[0], 0x06040200u), o1 = __builtin_amdgcn_perm(b_[1], b_[0], 0x07050301u); \
        v4u fe, fo; fe[0] = __builtin_bit_cast(unsigned, __builtin_amdgcn_cvt_scalef32_pk_bf16_fp8(e0, 1.0f, false)); fe[1] = __builtin_bit_cast(unsigned, __builtin_amdgcn_cvt_scalef32_pk_bf16_fp8(e0, 1.0f, true)); \
        fe[2] = __builtin_bit_cast(unsigned, __builtin_amdgcn_cvt_scalef32_pk_bf16_fp8(e1, 1.0f, false)); fe[3] = __builtin_bit_cast(unsigned, __builtin_amdgcn_cvt_scalef32_pk_bf16_fp8(e1, 1.0f, true)); \
        fo[0] = __builtin_bit_cast(unsigned, __builtin_amdgcn_cvt_scalef32_pk_bf16_fp8(o0, 1.0f, false)); fo[1] = __builtin_bit_cast(unsigned, __builtin_amdgcn_cvt_scalef32_pk_bf16_fp8(o0, 1.0f, true)); \
        fo[2] = __builtin_bit_cast(unsigned, __builtin_amdgcn_cvt_scalef32_pk_bf16_fp8(o1, 1.0f, false)); fo[3] = __builtin_bit_cast(unsigned, __builtin_amdgcn_cvt_scalef32_pk_bf16_fp8(o1, 1.0f, true)); \
        o[2 * dg] = MFMA16(Ap[ST], __builtin_bit_cast(bf16x8, fe), o[2 * dg]); o[2 * dg + 1] = MFMA16(Ap[ST], __builtin_bit_cast(bf16x8, fo), o[2 * dg + 1]); } } while (0)
#define AT_GRAB(dst) do { int b_ = 0; if (lane == 0) b_ = (int)xb_add(ctr, 4u); (dst) = __builtin_amdgcn_readfirstlane(b_); } while (0)
#define AT_ISSUE() do { pend = 0; if (lane == 0) pend = (int)xb_add(ctr, 4u); } while (0)
#define AT_TAKE(dst) do { (dst) = __builtin_amdgcn_readfirstlane(pend); } while (0)
__device__ __forceinline__ void phase_attn(ArgsP ap, LW lds_, int jl) {
    const CONSTAS Args& a = *ap; const Ctx c = make_ctx(lds_); GAS unsigned char* ws = opaque_ws(a.ws); const GAS bf16* PROJ = (const GAS bf16*)(ws + WS_PROJ); const GAS unsigned short* SEL = (const GAS unsigned short*)(ws + WS_SEL); GAS bf16* MIXO = (GAS bf16*)(ws + WS_MIXO); const GAS unsigned char* K8 = ws + WS_K8; const GAS unsigned char* V8 = ws + WS_V8;
    GAS unsigned* acnt = (GAS unsigned*)(ws + WS_CTL) + CW_ACNT + 64 * jl;
    LAS bf16* kt = (LAS bf16*)(c.lds + c.wave * 19456); LAS bf16* vt = kt + 32 * LVA; LAS unsigned short* ksm = (LAS unsigned short*)(kt + 64 * LVA);
    const int lane = c.lane, c16 = lane & 15, q4 = lane >> 4, r8 = lane >> 3, c8 = lane & 7; const int x = (int)(xb_xcc_id() & 7u);
    const GAS char* pb = (const GAS char*)PROJ;
    for (int pp = 0; pp < 8; ++pp) { const int pool = (x + pp) & 7, g = pool & 3, half = pool >> 2; GAS unsigned* ctr = acnt + pool; const int QF = half ? T / 2 - 256 : T / 2;        const unsigned coff = (unsigned)(g * 128 + 16 * c8);
#define AT_TQ(q) ((half ? T / 2 - 1 : T - 1) - (q))
        int nb; AT_GRAB(nb);
        if (nb < QF) {
            int cb = nb, ci = 0, pend = 0; AT_ISSUE();
            int t = AT_TQ(cb); LAS unsigned short* ksc = ksm; LAS unsigned short* ksn = ksm + 256;
#pragma unroll
            for (int i = 0; i < 4; ++i) ksc[lane + 64 * i] = SEL[(size_t)t * 256 + lane + 64 * i];
            long Bq[4];
#pragma unroll
            for (int ks = 0; ks < 4; ++ks) { bf16x8 z = {0, 0, 0, 0, 0, 0, 0, 0}; if (c16 < 4) z = *(const GAS bf16x8*)(pb + (unsigned)((t * NO + OC_Q + (4 * g + c16) * 128 + 32 * ks + 8 * q4) * 2)); AT_Q8(Bq[ks], z); }
            v4u s0[4], s1[4], s2[4], s3[4];
            AT_LOAD(s0, K8, ksc, 0); AT_LOAD(s1, K8, ksc, 1); AT_LOAD(s2, K8, ksc, 2); AT_LOAD(s3, K8, ksc, 3);
            for (;;) {
                if (ci == 3) AT_TAKE(nb);
                const bool has_next = (ci < 3) || (nb < QF); const int tn = has_next ? AT_TQ(ci < 3 ? cb + ci + 1 : nb) : t;
                f32x4 lg[16]; unsigned short kreg[4]; long Bqn[4];
                AT_WRITE_K8(kt, s0); AT_LOAD(s0, K8, ksc, 4);
#pragma unroll
                for (int i = 0; i < 4; ++i) kreg[i] = SEL[(size_t)tn * 256 + lane + 64 * i];
                AT_QK8(kt, 0);
                AT_WRITE_K8(vt, s1); AT_LOAD(s1, K8, ksc, 5); AT_QK8(vt, 1);
                AT_WRITE_K8(kt, s2); AT_LOAD(s2, K8, ksc, 6); AT_QK8(kt, 2);
                AT_WRITE_K8(vt, s3); AT_LOAD(s3, K8, ksc, 7); AT_QK8(vt, 3);
                AT_WRITE_K8(kt, s0); AT_LOAD(s0, V8, ksc, 0); AT_QK8(kt, 4);
                AT_WRITE_K8(vt, s1); AT_LOAD(s1, V8, ksc, 1); AT_QK8(vt, 5);
                AT_WRITE_K8(kt, s2); AT_LOAD(s2, V8, ksc, 2);
#pragma unroll
                for (int i = 0; i < 4; ++i) ksn[lane + 64 * i] = kreg[i];
                AT_QK8(kt, 6);
                AT_WRITE_K8(vt, s3); AT_LOAD(s3, V8, ksc, 3); AT_QK8(vt, 7);
                float m = -1e30f;
#pragma unroll
                for (int kk = 0; kk < 16; ++kk)
#pragma unroll
                    for (int rg = 0; rg < 4; ++rg) m = fmaxf(m, lg[kk][rg]);
                m = fmaxf(m, __shfl_xor(m, 16)); m = fmaxf(m, __shfl_xor(m, 32));
                float ssum = 0.f; bf16x8 Ap[8]; const float sc = RSQ_DK * 0.015625f; const float msc = m * sc;
#pragma unroll
                for (int ks2 = 0; ks2 < 8; ++ks2) { float e[8];
#pragma unroll
                    for (int j = 0; j < 8; ++j) { e[j] = __expf(lg[2 * ks2 + (j >> 2)][j & 3] * sc - msc); ssum += e[j]; }
                    v4u pw; pw.x = pk2(e[0], e[1]); pw.y = pk2(e[2], e[3]); pw.z = pk2(e[4], e[5]); pw.w = pk2(e[6], e[7]); Ap[ks2] = __builtin_bit_cast(bf16x8, pw); __builtin_amdgcn_sched_barrier(0); }
                ssum += __shfl_xor(ssum, 16); ssum += __shfl_xor(ssum, 32);
                f32x4 o[8];
#pragma unroll
                for (int dt = 0; dt < 8; ++dt) o[dt] = (f32x4){0.f, 0.f, 0.f, 0.f};
                AT_WRITE_K8(kt, s0); AT_LOAD(s0, V8, ksc, 4); AT_PV8(kt, 0);
                AT_WRITE_K8(vt, s1); AT_LOAD(s1, V8, ksc, 5);
                AT_PV8(vt, 1);
                AT_WRITE_K8(kt, s2); AT_LOAD(s2, V8, ksc, 6); AT_PV8(kt, 2);
                AT_WRITE_K8(vt, s3); AT_LOAD(s3, V8, ksc, 7); AT_PV8(vt, 3);
                AT_WRITE_K8(kt, s0); AT_LOAD(s0, K8, ksn, 0); AT_PV8(kt, 4);
                AT_WRITE_K8(vt, s1); AT_LOAD(s1, K8, ksn, 1);
#pragma unroll
                for (int ks = 0; ks < 4; ++ks) { bf16x8 z = {0, 0, 0, 0, 0, 0, 0, 0}; if (c16 < 4) z = *(const GAS bf16x8*)(pb + (unsigned)((tn * NO + OC_Q + (4 * g + c16) * 128 + 32 * ks + 8 * q4) * 2)); AT_Q8(Bqn[ks], z); }
                AT_PV8(vt, 5);
                AT_WRITE_K8(kt, s2); AT_LOAD(s2, K8, ksn, 2); AT_PV8(kt, 6);
                AT_WRITE_K8(vt, s3); AT_LOAD(s3, K8, ksn, 3); AT_PV8(vt, 7);
                float inv[4];
#pragma unroll
                for (int rg = 0; rg < 4; ++rg) inv[rg] = 0.0625f / __shfl(ssum, rg);
                if (q4 == 0) {
#pragma unroll
                    for (int rg = 0; rg < 4; ++rg)
#pragma unroll
                        for (int dt = 0; dt < 8; ++dt) kt[rg * 128 + 32 * (dt >> 1) + 2 * c16 + (dt & 1)] = (bf16)f2bf(o[dt][rg] * inv[rg]);
                }
                const v4u ov = *(const LAS v4u*)(kt + q4 * 128 + 8 * c16);
                *(GAS v4u*)(MIXO + (size_t)t * D + (4 * g + q4) * 128 + 8 * c16) = ov;
                if (!has_next) break;
#pragma unroll
                for (int ks = 0; ks < 4; ++ks) Bq[ks] = Bqn[ks];
                t = tn; { LAS unsigned short* tmp = ksc; ksc = ksn; ksn = tmp; }
                if (ci < 3) ++ci; else { cb = nb; ci = 0; AT_ISSUE(); }
            }
        }
        while (nb < T / 2) { for (int q = nb; q < nb + 4; ++q) attn_task(PROJ, K8, V8, SEL, MIXO, kt, vt, ksm, AT_TQ(q), g, lane); AT_GRAB(nb); }
#undef AT_TQ
    }
}

constexpr int N_PHASES = 1 + 10 * DEPTH;
#ifndef PHASE_MASK
#define PHASE_MASK 0xFFFF
#endif
#define EN(k) ((PHASE_MASK >> (k)) & 1)
#ifndef REP_MASK
#define REP_MASK 0
#endif
#define REPS(k) for (int rep_ = 0; rep_ < 1 + ((REP_MASK >> (k)) & 1); ++rep_)
__global__ void __launch_bounds__(NTHR, 2) fwd(Args a) {
    extern __shared__ __attribute__((aligned(16))) unsigned char lds_raw[];
    int wave_s_ = __builtin_amdgcn_readfirstlane((int)(threadIdx.x >> 6)); asm volatile("" : "+s"(wave_s_)); const int wave_s = wave_s_;
    LW lds; lds.p = (LAS unsigned char*)lds_raw; lds.w = wave_s;
#define LEADER() (wave_s == 0 && lane_id() == 0)
    volatile LAS unsigned* xbw = (volatile LAS unsigned*)(lds.p + LDS_BYTES - 64);
    if (threadIdx.x < 16) xbw[threadIdx.x] = 0u;
    __syncthreads();
    GAS unsigned char* const ws0 = (GAS unsigned char*)a.ws;
    XcdBarrier bar; bar.bar = (GAS unsigned*)(ws0 + WS_CTL) + CW_BAR; bar.x = 0; bar.st = xbw;
    const int lo = a.ph_lo, hi = a.ph_hi;
    if (hi - lo > 1) bar = xcd_barrier_post((GAS unsigned*)(ws0 + WS_CTL) + CW_BAR, xbw, LEADER());
#define IN(k) (lo <= (k) && (k) < hi)
#define SEAM(k) do { if (IN(k) && IN((k) + 1)) { XcdBarrier b2_ = bar; b2_.bar = (GAS unsigned*)opaque_ws((const void*)bar.bar); xcd_barrier(b2_, LEADER()); } } while (0)
    if (EN(0) && IN(0)) REPS(0) { phase_prologue(opaque_args(), lds); } SEAM(0);
    for (int L = 0; L < DEPTH; ++L) {
        const int base = 1 + 10 * L, jl = L >> 1; const bool even = (L & 1) == 0; GAS unsigned char* ws = opaque_ws(a.ws);
        if (EN(1) && IN(base)) REPS(1) {
            const int N = even ? NE : NO;
            pg8::Gemm g{(const pg8::bf16_t*)(ws + WS_HB), (const pg8::bf16_t*)(ws + (even ? WS_WINE : WS_WINO)) + (size_t)jl * N * D, T, N, D};
            pg8::StaticOrder S; S.init(T, N, (int)gridDim.x, (int)blockIdx.x);
            pg8::EpiProj E{(PG8_GAS pg8::bf16_t*)(ws + WS_PROJ), N, N / 256 - 1, (PG8_GAS float*)(ws + WS_SMALL)};
            pg8::gemm_phase<pg8::EpiProj, pg8::StaticOrder, false>((PG8_LAS unsigned char*)lds.p, g, S, E, nullptr, wave_s);
        }
        SEAM(base);
        if (even) {
            if (EN(2) && IN(base + 1)) REPS(2) phase_chunk_a(opaque_args(), lds, jl);
            SEAM(base + 1);
            if (EN(3) && IN(base + 2)) phase_scan(opaque_args(), lds);
            SEAM(base + 2);
            if (EN(4) && IN(base + 3)) REPS(4) phase_chunk_c(opaque_args(), lds, jl);
            SEAM(base + 3);
        } else {
            if (EN(5) && IN(base + 1)) phase_rope(opaque_args(), lds);
            SEAM(base + 1);
            if (EN(6) && IN(base + 2)) REPS(6) phase_index(opaque_args(), lds);
            SEAM(base + 2);
            if (EN(7) && IN(base + 3)) phase_attn(opaque_args(), lds, jl);
            SEAM(base + 3);
        }
        if (EN(8) && IN(base + 4)) REPS(8) {
            pg8::Gemm g{(const pg8::bf16_t*)(ws + WS_MIXO), (const pg8::bf16_t*)(ws + WS_WOUT) + (size_t)((even ? 0 : 2) + jl) * D * D, T, D, D};
            pg8::StaticOrder S; S.init(T, D, (int)gridDim.x, (int)blockIdx.x);
            pg8::EpiPlain E{(PG8_GAS pg8::bf16_t*)(ws + WS_MIX), D, 8};
            pg8::gemm_phase<pg8::EpiPlain, pg8::StaticOrder, false>((PG8_LAS unsigned char*)lds.p, g, S, E, nullptr, wave_s);
        }
        SEAM(base + 4);
        if (EN(9) && IN(base + 5)) phase_ln<0>(opaque_args(), lds, L);
        SEAM(base + 5);
        if ((EN(11) && IN(base + 7)) || (EN(12) && IN(base + 8))) {
            const GAS unsigned* cnt = (const GAS unsigned*)(ws + WS_CTL) + CW_CNT + 64 * L;
            pg8::MoeOrder S; { int acc = 0;
#pragma unroll
                for (int e = 0; e < 16; ++e) { S.toff[e] = acc; S.cnt[e] = (int)__builtin_amdgcn_readfirstlane((int)cnt[e]); acc += (S.cnt[e] + 255) >> 8; } S.toff[16] = acc; }
            S.list = (const PG8_GAS int*)(ws + WS_LIST); S.ldl = T;
            S.G = (int)gridDim.x; S.c = (int)blockIdx.x;
            if (EN(11) && IN(base + 7)) REPS(11) { S.ncol = 4;
                pg8::Gemm g{(const pg8::bf16_t*)(ws + WS_HB), (const pg8::bf16_t*)(ws + WS_WGU) + (size_t)L * 16 * 1024 * D, XROWS, 1024, D};
                pg8::EpiGU E{(PG8_GAS pg8::bf16_t*)(ws + WS_HMID), (const PG8_GAS float*)(ws + WS_GLIST), T};
                pg8::gemm_phase<pg8::EpiGU, pg8::MoeOrder, false, true>((PG8_LAS unsigned char*)lds.p, g, S, E, nullptr, wave_s); }
            SEAM(base + 7);
            if (EN(12) && IN(base + 8)) REPS(12) { S.ncol = 8;
                pg8::Gemm g{(const pg8::bf16_t*)(ws + WS_HMID), (const pg8::bf16_t*)(ws + WS_WDN) + (size_t)L * 16 * D * 512, XROWS, D, 512};
                pg8::EpiF8 E{(PG8_GAS unsigned char*)(ws + WS_Y), D, 8};
                pg8::gemm_phase<pg8::EpiF8, pg8::MoeOrder, false>((PG8_LAS unsigned char*)lds.p, g, S, E, nullptr, wave_s); }
        }
        SEAM(base + 8);
        if (EN(13) && IN(base + 9)) phase_ln<1>(opaque_args(), lds, L);
        SEAM(base + 9);
    }
#undef IN
#undef SEAM
}

#ifndef N_LAUNCH_MODE
#define N_LAUNCH_MODE 1
#endif
extern "C" void kernel_launch(void* const* d_in, const int* in_sizes, int n_in, void* d_out, int out_size, void* d_ws, size_t ws_size, hipStream_t stream) {
    static int grid = 0;
    if (grid == 0) {
        if (n_in != 22 || out_size != T * D || ws_size < WS_END) { fprintf(stderr, "kernel_launch: unexpected shapes (n_in %d out %d ws %zu need %zu)\n", n_in, out_size, ws_size, (size_t)WS_END); grid = -1; return; }
        int dev = 0, cus = 0, per_cu = 0;
        if (hipGetDevice(&dev) != hipSuccess || hipDeviceGetAttribute(&cus, hipDeviceAttributeMultiprocessorCount, dev) != hipSuccess) { grid = -1; return; }
        if (hipFuncSetAttribute((const void*)fwd, hipFuncAttributeMaxDynamicSharedMemorySize, LDS_BYTES) != hipSuccess) { fprintf(stderr, "kernel_launch: hipFuncSetAttribute failed\n"); grid = -1; return; }
        if (hipOccupancyMaxActiveBlocksPerMultiprocessor(&per_cu, (const void*)fwd, NTHR, LDS_BYTES) != hipSuccess || per_cu < 1) fprintf(stderr, "kernel_launch: occupancy query says %d\n", per_cu);
        (void)hipGetLastError();
        grid = cus;
    }
    if (grid < 0) return;
    (void)hipMemsetAsync((char*)d_ws + WS_CTL, 0, CTL_ZERO_BYTES, stream);
    Args a{};
    a.x = (const float*)d_in[0]; a.pos = (const int*)d_in[1]; a.ab_w_in = (const float*)d_in[2]; a.ab_conv_w = (const float*)d_in[3]; a.ab_igate_b = (const float*)d_in[4]; a.ab_fgate_b = (const float*)d_in[5];
    a.ab_gla_w2 = (const float*)d_in[6]; a.ab_gla_b = (const float*)d_in[7]; a.ab_mnorm = (const float*)d_in[8]; a.ab_gnorm = (const float*)d_in[9]; a.ab_w_out = (const float*)d_in[10];
    a.c_w_in = (const float*)d_in[11]; a.c_w_out = (const float*)d_in[12]; a.router_w = (const float*)d_in[13]; a.router_b = (const float*)d_in[14];
    a.moe_gate = (const float*)d_in[15]; a.moe_up = (const float*)d_in[16]; a.moe_down = (const float*)d_in[17];
    a.ln_mix_g = (const float*)d_in[18]; a.ln_mix_b = (const float*)d_in[19]; a.ln_ffn_g = (const float*)d_in[20]; a.ln_ffn_b = (const float*)d_in[21];
    a.out = (float*)d_out; a.ws = (unsigned char*)d_ws;
#if N_LAUNCH_MODE == 1
    a.ph_lo = 0; a.ph_hi = N_PHASES;
    hipLaunchKernelGGL(fwd, dim3(grid), dim3(NTHR), LDS_BYTES, stream, a);
#else
    for (int p = 0; p < N_PHASES; ++p) { a.ph_lo = p; a.ph_hi = p + 1; hipLaunchKernelGGL(fwd, dim3(grid), dim3(NTHR), LDS_BYTES, stream, a); }
#endif
}
```
